# Optimizing an MI355X kernel written in HIP

```python
import math
import jax, jax.numpy as jnp
from jax import lax
import numpy as np

D_MODEL = 1024
BATCH = 16
SEQ = 256
DEPTH = 2
DEC_BATCH = 2
DEC_SEQ = 2048
PAST_LEN = 256

GRID_W = 64
D_MIX = D_MODEL
D_ATTN = D_MIX // 2
D_CONV = D_MIX - D_ATTN
N_HEADS = 4
HEAD_DIM = D_ATTN // (2 * N_HEADS)
V_DIM = 2 * HEAD_DIM
CONV_W = 3
D_FF = 2816
ROPE_BASE = 10000.0
EPS = 1e-6
Q_BLOCK = 128
N_MOD = 6
D_IN = 3 * D_ATTN + 3 * D_CONV
SPLITS = (D_ATTN, 2 * D_ATTN, 3 * D_ATTN, 3 * D_ATTN + D_CONV, 3 * D_ATTN + 2 * D_CONV)

kernel_name = 'hybrid_diffattn_shortconv_dit_step'


def _rmsnorm(x, g):
    xf = x.astype(jnp.float32)
    r = lax.rsqrt(jnp.mean(xf * xf, axis=-1, keepdims=True) + EPS)
    return (xf * r).astype(x.dtype) * g


def _dwconv3(u, w):
    up = jnp.pad(u, ((0, 0), (1, 1), (0, 0)))
    return up[:, :-2] * w[0] + up[:, 1:-1] * w[1] + up[:, 2:] * w[2]


def _grid_angles(n_tok):
    rows = n_tok // GRID_W
    row = jnp.repeat(jnp.arange(rows, dtype=jnp.float32), GRID_W)
    col = jnp.tile(jnp.arange(GRID_W, dtype=jnp.float32), rows)
    n_freq = HEAD_DIM // 4
    inv = ROPE_BASE ** (-jnp.arange(n_freq, dtype=jnp.float32) / n_freq)
    return row[:, None] * inv[None], col[:, None] * inv[None]


def _rot_axis(x, ang):
    half = x.shape[-1] // 2
    cos = jnp.cos(ang)[None, :, None, None, :].astype(x.dtype)
    sin = jnp.sin(ang)[None, :, None, None, :].astype(x.dtype)
    x1, x2 = x[..., :half], x[..., half:]
    return jnp.concatenate([x1 * cos - x2 * sin, x2 * cos + x1 * sin], axis=-1)


def _rope_2d(x, ang_row, ang_col):
    h = HEAD_DIM // 2
    return jnp.concatenate([_rot_axis(x[..., :h], ang_row), _rot_axis(x[..., h:], ang_col)], axis=-1)


def _diff_attention(q, k, v, lam):
    bsz, lq = q.shape[:2]
    nb = lq // Q_BLOCK
    qb = q.reshape(bsz, nb, Q_BLOCK, N_HEADS, 2, HEAD_DIM).transpose(1, 0, 2, 3, 4, 5)
    scale = HEAD_DIM ** -0.5

    def block(qblk):
        s = jnp.einsum('bqhsd,bkhsd->bhsqk', qblk, k).astype(jnp.float32) * scale
        p = jax.nn.softmax(s, axis=-1)
        a = p[:, :, 0] - lam * p[:, :, 1]
        return jnp.einsum('bhqk,bkhe->bqhe', a.astype(v.dtype), v)

    o = lax.map(block, qb)
    return o.transpose(1, 0, 2, 3, 4).reshape(bsz, lq, N_HEADS, V_DIM)


def setup_inputs(seed: int = 0) -> dict:
    key = jax.random.key(seed)
    ks = jax.random.split(key, 24)
    f32 = jnp.float32
    nrm = lambda k, shape, s: jax.random.normal(k, shape, f32) * s
    return {
        'x_prompt': nrm(ks[0], (BATCH, SEQ, D_MODEL), 1.0),
        'x_sample': nrm(ks[1], (DEC_BATCH, DEC_SEQ, D_MODEL), 1.0),
        'cache_k': nrm(ks[2], (DEC_BATCH, DEPTH, PAST_LEN, N_HEADS, 2, HEAD_DIM), 1.0),
        'cache_v': nrm(ks[3], (DEC_BATCH, DEPTH, PAST_LEN, N_HEADS, V_DIM), 1.0),
        'c': nrm(ks[4], (DEC_BATCH, D_MODEL), 1.0),
        'c_ctx': nrm(ks[5], (D_MODEL,), 1.0),
        'w_mod': nrm(ks[6], (DEPTH, D_MODEL, N_MOD * D_MODEL), D_MODEL ** -0.5),
        'b_mod': nrm(ks[7], (DEPTH, N_MOD * D_MODEL), 0.02),
        'norm1_g': 1.0 + nrm(ks[8], (DEPTH, D_MODEL), 0.02),
        'w_in': nrm(ks[9], (DEPTH, D_MODEL, D_IN), D_MODEL ** -0.5),
        'q_norm_g': 1.0 + nrm(ks[10], (DEPTH, HEAD_DIM), 0.02),
        'k_norm_g': 1.0 + nrm(ks[11], (DEPTH, HEAD_DIM), 0.02),
        'lambda_q1': nrm(ks[12], (DEPTH, HEAD_DIM), 0.1),
        'lambda_k1': nrm(ks[13], (DEPTH, HEAD_DIM), 0.1),
        'lambda_q2': nrm(ks[14], (DEPTH, HEAD_DIM), 0.1),
        'lambda_k2': nrm(ks[15], (DEPTH, HEAD_DIM), 0.1),
        'subln_g': 1.0 + nrm(ks[16], (DEPTH, V_DIM), 0.02),
        'conv_w': nrm(ks[17], (DEPTH, CONV_W, D_CONV), CONV_W ** -0.5),
        'conv_norm_g': 1.0 + nrm(ks[18], (DEPTH, D_CONV), 0.02),
        'w_out': nrm(ks[19], (DEPTH, D_MIX, D_MODEL), D_MIX ** -0.5),
        'norm2_g': 1.0 + nrm(ks[20], (DEPTH, D_MODEL), 0.02),
        'w_up': nrm(ks[21], (DEPTH, D_MODEL, 2 * D_FF), D_MODEL ** -0.5),
        'ffn_conv_w': nrm(ks[22], (DEPTH, CONV_W, 2 * D_FF), CONV_W ** -0.5),
        'w_down': nrm(ks[23], (DEPTH, D_FF, D_MODEL), D_FF ** -0.5),
    }


def reference(x_prompt, x_sample, cache_k, cache_v, c, c_ctx, w_mod, b_mod, norm1_g, w_in,
              q_norm_g, k_norm_g, lambda_q1, lambda_k1, lambda_q2, lambda_k2, subln_g,
              conv_w, conv_norm_g, w_out, norm2_g, w_up, ffn_conv_w, w_down):

    def layer(l, x, cvec, ctx_kv, ang):
        m = (jax.nn.silu(cvec) @ w_mod[l] + b_mod[l])[..., None, :]
        sh1, sc1, g1, sh2, sc2, g2 = jnp.split(m, N_MOD, axis=-1)
        h = _rmsnorm(x, norm1_g[l]) * (1 + sc1) + sh1
        bsz, n = x.shape[:2]
        q, k, v, bg, cg, xc = jnp.split(h @ w_in[l], SPLITS, axis=-1)
        q = _rmsnorm(q.reshape(bsz, n, N_HEADS, 2, HEAD_DIM), q_norm_g[l])
        k = _rmsnorm(k.reshape(bsz, n, N_HEADS, 2, HEAD_DIM), k_norm_g[l])
        v = v.reshape(bsz, n, N_HEADS, V_DIM)
        if ang is None:
            k_all, v_all = k, v
        else:
            q = _rope_2d(q, *ang)
            k = _rope_2d(k, *ang)
            k_all = jnp.concatenate([ctx_kv[0], k], axis=1)
            v_all = jnp.concatenate([ctx_kv[1], v], axis=1)
        lam_init = 0.8 - 0.6 * math.exp(-0.3 * l)
        f = lambda a: a.astype(jnp.float32)
        lam = (jnp.exp(jnp.sum(f(lambda_q1[l]) * f(lambda_k1[l])))
               - jnp.exp(jnp.sum(f(lambda_q2[l]) * f(lambda_k2[l]))) + lam_init)
        o = _diff_attention(q, k_all, v_all, lam)
        o = (_rmsnorm(o, subln_g[l]) * (1.0 - lam_init)).reshape(bsz, n, D_ATTN)
        y = _rmsnorm(bg * _dwconv3(cg * xc, conv_w[l]), conv_norm_g[l])
        x = x + g1 * (jnp.concatenate([o, y], axis=-1) @ w_out[l])
        h2 = _rmsnorm(x, norm2_g[l]) * (1 + sc2) + sh2
        a, b = jnp.split(_dwconv3(h2 @ w_up[l], ffn_conv_w[l]), 2, axis=-1)
        x = x + g2 * ((jax.nn.silu(a) * b) @ w_down[l])
        return x, k, v

    xp = x_prompt
    ks_new, vs_new = [], []
    for l in range(DEPTH):
        xp, k_l, v_l = layer(l, xp, c_ctx, None, None)
        ks_new.append(k_l)
        vs_new.append(v_l)
    y_prompt = xp
    new_k = jnp.stack(ks_new, axis=1)
    new_v = jnp.stack(vs_new, axis=1)

    ang = _grid_angles(x_sample.shape[1])
    xs = x_sample
    for l in range(DEPTH):
        xs, _, _ = layer(l, xs, c, (cache_k[:, l], cache_v[:, l]), ang)
    y_sample = xs

    return (y_prompt, y_sample, new_k, new_v)
```

```cpp
#include <hip/hip_runtime.h>
#include <hip/hip_cooperative_groups.h>
#include <cstdio>
#include <cstdint>
#include <math.h>
namespace cg = cooperative_groups;
#define GAS __attribute__((address_space(1)))
#define LAS __attribute__((address_space(3)))
namespace pg8 {
#define PG8_LAS __attribute__((address_space(3)))
typedef unsigned short bf16_t;
typedef short bf16x8 __attribute__((ext_vector_type(8)));
typedef float f32x4 __attribute__((ext_vector_type(4)));
typedef unsigned u32x4 __attribute__((ext_vector_type(4)));
constexpr int BM = 256, BK = 64, HALF = 128, HTB = HALF * BK * 2  , STAGE_BYTES = 8 * HTB, NXCD = 8, WGM = 8;

__host__ __device__ __forceinline__ int lds_byte(int r, int c) { const int st = (r >> 4) * 2 + (c >> 5), rr = r & 15, cc = c & 31, ob = rr * 64 + cc * 2; return st * 1024 + (ob ^ (((ob >> 9) & 1) << 5)); }
__host__ __device__ __forceinline__ void stage_rc(int b, int& R, int& C) { const int st = b / 1024, sb = b % 1024, swz = sb ^ (((sb >> 9) & 1) << 5); R = (st >> 1) * 16 + swz / 64; C = (st & 1) * 32 + (swz % 64) / 2; }
__host__ __device__ __forceinline__ int perm32(int rho) { const int n = rho >> 4, i = rho & 15; return 8 * (i >> 2) + 4 * n + (i & 3); }

struct Unit { int pm, pn; };
struct Gemm { const bf16_t* A; const bf16_t* Bt; int M, N, K; };

struct StaticOrder {
    int nM, nN, nwg, G, c;
    __host__ __device__ void init(int M, int N, int G_, int c_) { nM = M / BM; nN = N / BM; nwg = nM * nN; G = G_; c = c_; }
    __host__ __device__ bool next(int i, Unit& u) const {
        const long L = (long)i * G + c; if (L >= nwg) return false;
        int wgid = (int)L; { const int q = nwg / NXCD, r = nwg % NXCD, xcd = wgid % NXCD, off = wgid / NXCD; wgid = (xcd < r ? xcd * (q + 1) : r * (q + 1) + (xcd - r) * q) + off; }
        const int nig = WGM * nN, gid = wgid / nig, fm = gid * WGM, gsz = (nM - fm) < WGM ? (nM - fm) : WGM;
        u.pm = fm + ((wgid % nig) % gsz); u.pn = (wgid % nig) / gsz; return true;
    }
    __device__ __forceinline__ int arow(int pm) const { return pm * BM; }
    __device__ __forceinline__ void a_ready(const Unit&) const {}
    __device__ __forceinline__ void done(const Unit&) const {}
};
struct OrderUp : StaticOrder {
    __device__ __forceinline__ int arow(int pm) const { return pm < 16 ? pm * BM : 4096 + ((pm - 16) / 9) * 2048 + ((pm - 16) % 9) * 254 - 1; }
};

__device__ __forceinline__ unsigned cvt_pk_bf16(float lo, float hi) { unsigned r; asm volatile("v_cvt_pk_bf16_f32 %0, %1, %2" : "=v"(r) : "v"(lo), "v"(hi)); return r; }
__device__ __forceinline__ u32x4 pair16(f32x4 v0, f32x4 v1) {
    const unsigned ax = cvt_pk_bf16(v0[0], v0[1]), ay = cvt_pk_bf16(v0[2], v0[3]), bx = cvt_pk_bf16(v1[0], v1[1]), by = cvt_pk_bf16(v1[2], v1[3]);
    const auto rx = __builtin_amdgcn_permlane16_swap(ax, bx, false, false); const auto ry = __builtin_amdgcn_permlane16_swap(ay, by, false, false);
    return (u32x4){rx[0], ry[0], rx[1], ry[1]};
}
__device__ __forceinline__ int pair16_col(int fq) { return 16 * (fq & 1) + 8 * (fq >> 1); }
__device__ __forceinline__ void unpair16(u32x4 q, f32x4& v0, f32x4& v1) {
    const auto rx = __builtin_amdgcn_permlane16_swap(q[0], q[2], false, false); const auto ry = __builtin_amdgcn_permlane16_swap(q[1], q[3], false, false);
    v0 = (f32x4){__uint_as_float(rx[0] << 16), __uint_as_float(rx[0] & 0xffff0000u), __uint_as_float(ry[0] << 16), __uint_as_float(ry[0] & 0xffff0000u)};
    v1 = (f32x4){__uint_as_float(rx[1] << 16), __uint_as_float(rx[1] & 0xffff0000u), __uint_as_float(ry[1] << 16), __uint_as_float(ry[1] & 0xffff0000u)};
}
template <int AI, int XIN, int OUT> struct EpiRes {
    static constexpr bool PERM = false, AFTER_DRAIN = false;
    const float* xin0; const float* xin1; bf16_t* xr; float* out; const float* gate;
    bf16_t* xa; const float* gnext; const float* scnext; float* rowss;
    struct Pre { u32x4 q[XIN == 1 ? AI : 1][4][2]; };
    __device__ __forceinline__ void pre(const Unit& u, int wr, int wc, int fr, int fq, Pre& p) const {
        if (XIN == 1) { const int r0 = u.pm * (AI * HALF), colp = u.pn * BM + wc * 32 + pair16_col(fq);
#pragma unroll
            for (int ai = 0; ai < AI; ++ai)
#pragma unroll
                for (int m = 0; m < 4; ++m)
#pragma unroll
                    for (int bj = 0; bj < 2; ++bj) p.q[ai][m][bj] = *(const u32x4*)(xr + (size_t)(r0 + ai * HALF + wr * 64 + m * 16 + fr) * 1024 + colp + bj * HALF); }
    }
    __device__ __forceinline__ void operator()(const f32x4 (&acc)[AI][2][4][2], const Unit& u, int wr, int wc, int fr_, int fq_, const Pre& pre) const {
        int fr = fr_, fq = fq_; asm volatile("" : "+v"(fr), "+v"(fq));
        const int r0 = u.pm * (AI * HALF);
        const float* xb = (r0 < 4096) ? xin0 + (size_t)r0 * 1024 : xin1 + (size_t)(r0 - 4096) * 1024;
        const int grp = (r0 < 4096) ? 0 : 1 + ((r0 - 4096) >> 11);
        const int col0 = u.pn * BM + wc * 32 + 4 * fq, colp = u.pn * BM + wc * 32 + pair16_col(fq);
        f32x4 gv[2][2], gs[2][2];
#pragma unroll
        for (int bj = 0; bj < 2; ++bj)
#pragma unroll
            for (int n = 0; n < 2; ++n) { const int c = col0 + bj * HALF + n * 16; gv[bj][n] = *(const f32x4*)(gate + (size_t)grp * 6144 + c);
                if (xa) gs[bj][n] = *(const f32x4*)(gnext + c) * (*(const f32x4*)(scnext + (size_t)grp * 6144 + c) + 1.f); else gs[bj][n] = gv[bj][n]; }
        f32x4 xin[XIN == 0 ? AI : 1][4][2][2];
        if (XIN == 0) {
#pragma unroll
            for (int ai = 0; ai < AI; ++ai)
#pragma unroll
                for (int m = 0; m < 4; ++m)
#pragma unroll
                    for (int bj = 0; bj < 2; ++bj) { const int rl = ai * HALF + wr * 64 + m * 16 + fr;
                        xin[ai][m][bj][0] = *(const f32x4*)(xb + (size_t)rl * 1024 + col0 + bj * HALF); xin[ai][m][bj][1] = *(const f32x4*)(xb + (size_t)rl * 1024 + col0 + bj * HALF + 16); } }
#pragma unroll
        for (int ai = 0; ai < AI; ++ai)
#pragma unroll
            for (int m = 0; m < 4; ++m) { const int rl = ai * HALF + wr * 64 + m * 16 + fr; float ssq = 0.f;
#pragma unroll
                for (int bj = 0; bj < 2; ++bj) { f32x4 xv[2], o[2], yv[2];
                    if (XIN == 0) { xv[0] = xin[XIN == 0 ? ai : 0][m][bj][0]; xv[1] = xin[XIN == 0 ? ai : 0][m][bj][1]; }
                    else unpair16(pre.q[ai][m][bj], xv[0], xv[1]);
#pragma unroll
                    for (int n = 0; n < 2; ++n) { o[n] = xv[n] + gv[bj][n] * acc[ai][bj][m][n];
                        if (OUT == 0) __builtin_nontemporal_store(o[n], (f32x4*)(out + (size_t)(r0 + rl) * 1024 + col0 + bj * HALF + n * 16));
                        if (xa) { ssq += (o[n][0] * o[n][0] + o[n][1] * o[n][1]) + (o[n][2] * o[n][2] + o[n][3] * o[n][3]); yv[n] = o[n] * gs[bj][n]; } }
                    if (OUT == 1) *(u32x4*)(xr + (size_t)(r0 + rl) * 1024 + colp + bj * HALF) = pair16(o[0], o[1]);
                    if (xa) *(u32x4*)(xa + (size_t)(r0 + rl) * 1024 + colp + bj * HALF) = pair16(yv[0], yv[1]); }
                if (xa) { ssq += __shfl_xor(ssq, 16); ssq += __shfl_xor(ssq, 32); if (fq == 0) atomicAdd(rowss + r0 + rl, ssq); } }
    }
};
typedef _Float16 h2_t __attribute__((ext_vector_type(2)));
template <int CTRL> __device__ __forceinline__ h2_t dpph(h2_t old, h2_t src) {
    return __builtin_bit_cast(h2_t, __builtin_amdgcn_update_dpp(__builtin_bit_cast(int, old), __builtin_bit_cast(int, src), CTRL, 0xf, 0xf, false)); }
__device__ __forceinline__ h2_t pkh(float a, float b) { return __builtin_bit_cast(h2_t, __builtin_amdgcn_cvt_pkrtz(a, b)); }
struct EpiSwiglu {
    static constexpr bool PERM = true, AFTER_DRAIN = false;
    const float* cw; bf16_t* act; PG8_LAS float* edge; const float* rowss; const float* bias;
    __device__ __forceinline__ void operator()(f32x4 (&acc)[2][2][4][2], const Unit& u, int wr, int wc, int fr_, int fq_) const {
        int fr = fr_, fq = fq_; asm volatile("" : "+v"(fr), "+v"(fq));
        int row0, vlo = 0, vhi = 256, olo = 0, ohi = 256;
        if (u.pm < 16) row0 = u.pm * 256;
        else { const int b = (u.pm - 16) / 9, i = (u.pm - 16) % 9, t0 = 254 * i - 1; row0 = 4096 + 2048 * b + t0; vlo = (i == 0) ? 1 : 0; vhi = (2048 - t0) < 256 ? (2048 - t0) : 256; olo = 1; ohi = vhi < 255 ? vhi : 255; }
        h2_t U[2][2][4][2][2];
        {
            const int grp = u.pm < 16 ? 0 : 1 + (u.pm - 16) / 9;
            const bool need_mask = vlo > 0 || vhi < 256;
            f32x4 bv[2][2];
#pragma unroll
            for (int bj = 0; bj < 2; ++bj)
#pragma unroll
                for (int n = 0; n < 2; ++n) bv[bj][n] = *(const f32x4*)(bias + (size_t)grp * 5632 + u.pn * BM + bj * HALF + wc * 32 + 8 * fq + 4 * n);
            if (!need_mask) {
#pragma unroll
                for (int ai = 0; ai < 2; ++ai)
#pragma unroll
                    for (int m = 0; m < 4; ++m) { const float rs = rsqrtf(rowss[row0 + ai * HALF + wr * 64 + m * 16 + fr] * (1.f / 1024.f) + 1e-6f);
#pragma unroll
                        for (int bj = 0; bj < 2; ++bj)
#pragma unroll
                            for (int n = 0; n < 2; ++n) { const f32x4 v = acc[ai][bj][m][n] * rs + bv[bj][n]; U[ai][bj][m][n][0] = pkh(v[0], v[1]); U[ai][bj][m][n][1] = pkh(v[2], v[3]); } }
            } else {
#pragma unroll
                for (int ai = 0; ai < 2; ++ai)
#pragma unroll
                    for (int m = 0; m < 4; ++m) { const int rho = ai * HALF + wr * 64 + m * 16 + fr; const bool ok = rho >= vlo && rho < vhi;
                        const float rs = rsqrtf(rowss[row0 + rho] * (1.f / 1024.f) + 1e-6f);
#pragma unroll
                        for (int bj = 0; bj < 2; ++bj)
#pragma unroll
                            for (int n = 0; n < 2; ++n) { f32x4 v = acc[ai][bj][m][n] * rs + bv[bj][n]; v[0] = ok ? v[0] : 0.f; v[1] = ok ? v[1] : 0.f; v[2] = ok ? v[2] : 0.f; v[3] = ok ? v[3] : 0.f;
                                U[ai][bj][m][n][0] = pkh(v[0], v[1]); U[ai][bj][m][n][1] = pkh(v[2], v[3]); } }
            }
        }
#pragma unroll
        for (int ai = 0; ai < 2; ++ai) { const int seg = ai * 2 + wr;
#pragma unroll
            for (int bj = 0; bj < 2; ++bj)
#pragma unroll
                for (int n = 0; n < 2; ++n) {
                    if (fr == 0)  { PG8_LAS h2_t* p = (PG8_LAS h2_t*)(edge + ((seg * 2 + 0) * 4 + wc) * 64 + (bj * 2 + n) * 16 + fq * 4); p[0] = U[ai][bj][0][n][0]; p[1] = U[ai][bj][0][n][1]; }
                    if (fr == 15) { PG8_LAS h2_t* p = (PG8_LAS h2_t*)(edge + ((seg * 2 + 1) * 4 + wc) * 64 + (bj * 2 + n) * 16 + fq * 4); p[0] = U[ai][bj][3][n][0]; p[1] = U[ai][bj][3][n][1]; } } }
        asm volatile("s_waitcnt lgkmcnt(0)" ::: "memory"); __builtin_amdgcn_s_barrier(); asm volatile("" ::: "memory");
        const int cj = u.pn * HALF + wc * 32 + 8 * fq;
        const h2_t zero2 = {(_Float16)0.f, (_Float16)0.f};
        uint2 keep[2][4];
#pragma unroll
        for (int n = 0; n < 2; ++n) {
            h2_t w[3][2][2];
#pragma unroll
            for (int tp = 0; tp < 3; ++tp)
#pragma unroll
                for (int bj = 0; bj < 2; ++bj) { const f32x4 wf = *(const f32x4*)(cw + tp * 5632 + bj * 2816 + cj + 4 * n); w[tp][bj][0] = pkh(wf[0], wf[1]); w[tp][bj][1] = pkh(wf[2], wf[3]); }
#pragma unroll
            for (int ai = 0; ai < 2; ++ai) { const int seg = ai * 2 + wr;
                h2_t above[2][2], below[2][2];
#pragma unroll
                for (int bj = 0; bj < 2; ++bj)
#pragma unroll
                    for (int p = 0; p < 2; ++p) {
                        above[bj][p] = seg > 0 ? ((const PG8_LAS h2_t*)(edge + (((seg - 1) * 2 + 1) * 4 + wc) * 64 + (bj * 2 + n) * 16 + fq * 4))[p] : zero2;
                        below[bj][p] = seg < 3 ? ((const PG8_LAS h2_t*)(edge + (((seg + 1) * 2 + 0) * 4 + wc) * 64 + (bj * 2 + n) * 16 + fq * 4))[p] : zero2; }
#pragma unroll
                for (int m = 0; m < 4; ++m) { const int rho = ai * HALF + wr * 64 + m * 16 + fr;
                    h2_t c[2][2];
#pragma unroll
                    for (int bj = 0; bj < 2; ++bj)
#pragma unroll
                        for (int p = 0; p < 2; ++p) { const h2_t cur = U[ai][bj][m][n][p];
                            const h2_t oldu = (m > 0) ? dpph<0x121>(U[ai][bj][m > 0 ? m - 1 : 0][n][p], U[ai][bj][m > 0 ? m - 1 : 0][n][p]) : above[bj][p];
                            const h2_t up = dpph<0x111>(oldu, cur);
                            const h2_t oldd = (m < 3) ? dpph<0x12F>(U[ai][bj][m < 3 ? m + 1 : 3][n][p], U[ai][bj][m < 3 ? m + 1 : 3][n][p]) : below[bj][p];
                            const h2_t dn = dpph<0x101>(oldd, cur);
                            c[bj][p] = w[1][bj][p] * cur + w[0][bj][p] * up + w[2][bj][p] * dn; }
                    float r[4];
#pragma unroll
                    for (int e = 0; e < 4; ++e) { const float x = (float)c[0][e >> 1][e & 1], y = (float)c[1][e >> 1][e & 1];
                        r[e] = x * __builtin_amdgcn_rcpf(1.f + __builtin_amdgcn_exp2f(-1.4426950408889634f * x)) * y; }
                    uint2 o; o.x = cvt_pk_bf16(r[0], r[1]); o.y = cvt_pk_bf16(r[2], r[3]);
                    if (n == 0) keep[ai][m] = o;
                    else { u32x4 q; q.x = keep[ai][m].x; q.y = keep[ai][m].y; q.z = o.x; q.w = o.y;
                        if (rho >= olo && rho < ohi) *(u32x4*)(act + (size_t)(row0 + rho) * 2816 + cj) = q; } }
            }
        }
    }
};
template <class Epi, class Sched, bool ALIGN_EPI = false, bool SP2 = false>
__device__ __forceinline__ void gemm_phase(PG8_LAS unsigned char* lds, const Gemm g, const Sched& S, const Epi& E) {
    int tid_ = threadIdx.x; asm volatile("" : "+v"(tid_));
    const int tid = tid_, wid = __builtin_amdgcn_readfirstlane(tid >> 6), lane = tid & 63, wr = wid >> 2, wc = wid & 3, fr = lane & 15, fq = lane >> 4;
    const int K = g.K, nt = K / BK;
    unsigned voffA[2], voffB[2];
#pragma unroll
    for (int i = 0; i < 2; ++i) { int R, C; stage_rc(tid * 16 + i * 8192, R, C); const int Rb = Epi::PERM ? ((R & ~31) + perm32(R & 31)) : R;
        voffA[i] = (unsigned)(R * K + C) * 2u; voffB[i] = (unsigned)(Rb * K + C) * 2u; }
    const size_t kstep = (size_t)(BK * 2);
    const size_t hstep = (size_t)HALF * K * 2;
    const size_t tstep = 2 * hstep;
    const unsigned ldsw = (unsigned)wid * 1024u;
    const int aoff = lds_byte(wr * 64 + fr, fq * 8), boff = lds_byte(wc * 32 + fr, fq * 8);
#define PG8_SA(b, h) (((b) * 2 + (h)) * HTB)
#define PG8_SB(b, h) ((4 + (b) * 2 + (h)) * HTB)
#define PG8_STAGE(bufoff, gbase, voff) do { _Pragma("unroll") for (int _i = 0; _i < 2; ++_i) \
        __builtin_amdgcn_global_load_lds((const unsigned*)((const char*)(gbase) + (voff)[_i]), (PG8_LAS unsigned*)(lds + (bufoff) + ldsw + _i * 8192), 16, 0, 0); } while (0)
#define PG8_LDA(dst, b, h) do { _Pragma("unroll") for (int m = 0; m < 4; ++m) _Pragma("unroll") for (int k = 0; k < 2; ++k) dst[m][k] = *(const PG8_LAS bf16x8*)(lds + PG8_SA(b, h) + aoff + m * 2048 + k * 1024); } while (0)
#define PG8_LDB(dst, b, h) do { _Pragma("unroll") for (int n = 0; n < 2; ++n) _Pragma("unroll") for (int k = 0; k < 2; ++k) dst[n][k] = *(const PG8_LAS bf16x8*)(lds + PG8_SB(b, h) + boff + n * 2048 + k * 1024); } while (0)
#define PG8_MMA(ai, bj, At, Bt) do { __builtin_amdgcn_s_setprio(1); _Pragma("unroll") for (int m = 0; m < 4; ++m) _Pragma("unroll") for (int n = 0; n < 2; ++n) _Pragma("unroll") for (int k = 0; k < 2; ++k) \
        acc[ai][bj][m][n] = __builtin_amdgcn_mfma_f32_16x16x32_bf16(Bt[n][k], At[m][k], acc[ai][bj][m][n], 0, 0, 0); __builtin_amdgcn_s_setprio(0); } while (0)
#define PG8_WAIT_V(n) asm volatile("s_waitcnt vmcnt(" #n ")" ::: "memory")
#define PG8_WAIT_L(n) asm volatile("s_waitcnt lgkmcnt(" #n ")" ::: "memory")
#define PG8_BAR __builtin_amdgcn_s_barrier()
#define PG8_SCHED __builtin_amdgcn_sched_barrier(0)
    Unit cur, nxt; int ui = 0;
    if (!S.next(0, cur)) return;
    f32x4 acc[2][2][4][2];
#pragma unroll
    for (int a = 0; a < 2; ++a)
#pragma unroll
        for (int b = 0; b < 2; ++b)
#pragma unroll
            for (int m = 0; m < 4; ++m)
#pragma unroll
                for (int n = 0; n < 2; ++n) acc[a][b][m][n] = (f32x4){0.f, 0.f, 0.f, 0.f};
    bf16x8 At[4][2], B0[2][2], B1[2][2];
    const char* cA = (const char*)g.A + (size_t)S.arow(cur.pm) * (size_t)K * 2; const char* cB = (const char*)g.Bt + (size_t)cur.pn * tstep;
    S.a_ready(cur);
    if constexpr (SP2) {
        PG8_STAGE(PG8_SB(0, 0), cB, voffB); PG8_STAGE(PG8_SB(0, 1), cB + hstep, voffB); PG8_STAGE(PG8_SA(0, 0), cA, voffA); PG8_STAGE(PG8_SA(0, 1), cA + hstep, voffA);
        if (wr == 1) PG8_BAR;
        PG8_WAIT_V(2); PG8_BAR;
        PG8_STAGE(PG8_SB(1, 0), cB + kstep, voffB); PG8_STAGE(PG8_SA(1, 0), cA + kstep, voffA); PG8_STAGE(PG8_SB(1, 1), cB + hstep + kstep, voffB);
        PG8_WAIT_V(6); PG8_BAR;
    } else {
        PG8_STAGE(PG8_SB(0, 0), cB, voffB); PG8_STAGE(PG8_SA(0, 0), cA, voffA); PG8_STAGE(PG8_SB(0, 1), cB + hstep, voffB); PG8_STAGE(PG8_SA(0, 1), cA + hstep, voffA);
        if (wr == 1) PG8_BAR;
        PG8_WAIT_V(4); PG8_BAR;
        PG8_STAGE(PG8_SB(1, 0), cB + kstep, voffB); PG8_STAGE(PG8_SA(1, 0), cA + kstep, voffA); PG8_STAGE(PG8_SB(1, 1), cB + hstep + kstep, voffB);
        PG8_WAIT_V(6); PG8_BAR;
    }
    for (;;) {
        const bool has_next = S.next(ui + 1, nxt);
        const char* nA = has_next ? (const char*)g.A + (size_t)S.arow(nxt.pm) * (size_t)K * 2 : cA; const char* nB = has_next ? (const char*)g.Bt + (size_t)nxt.pn * tstep : cB;
        for (int t = 0; t < nt; t += 2) {
            const bool last = (t == nt - 2);
            const char* a1 = cA + (size_t)(t + 1) * kstep;
            const char* a2 = last ? nA : cA + (size_t)(t + 2) * kstep; const char* b2 = last ? nB : cB + (size_t)(t + 2) * kstep;
            const char* a3 = a2 + kstep; const char* b3 = b2 + kstep;
            if (last && has_next) S.a_ready(nxt);
            if constexpr (SP2) {
            PG8_LDB(B0, 0, 0); PG8_LDB(B1, 0, 1); PG8_SCHED; PG8_LDA(At, 0, 0); PG8_STAGE(PG8_SA(1, 1), a1 + hstep, voffA);
            PG8_WAIT_V(8); PG8_WAIT_L(0); PG8_BAR; PG8_MMA(0, 0, At, B0); PG8_MMA(0, 1, At, B1); PG8_BAR; PG8_SCHED;
            PG8_LDA(At, 0, 1); PG8_STAGE(PG8_SB(0, 0), b2, voffB); PG8_STAGE(PG8_SB(0, 1), b2 + hstep, voffB); PG8_STAGE(PG8_SA(0, 0), a2, voffA);
            PG8_WAIT_V(8); PG8_WAIT_L(0); PG8_BAR; PG8_MMA(1, 0, At, B0); PG8_MMA(1, 1, At, B1); PG8_BAR; PG8_SCHED;
            PG8_LDB(B0, 1, 0); PG8_LDB(B1, 1, 1); PG8_SCHED; PG8_LDA(At, 1, 0); PG8_STAGE(PG8_SA(0, 1), a2 + hstep, voffA);
            PG8_WAIT_V(8); PG8_WAIT_L(0); PG8_BAR; PG8_MMA(0, 0, At, B0); PG8_MMA(0, 1, At, B1); PG8_BAR; PG8_SCHED;
            PG8_LDA(At, 1, 1); PG8_STAGE(PG8_SB(1, 0), b3, voffB); PG8_STAGE(PG8_SB(1, 1), b3 + hstep, voffB); PG8_STAGE(PG8_SA(1, 0), a3, voffA);
            PG8_WAIT_V(8); PG8_WAIT_L(0); PG8_BAR; PG8_MMA(1, 0, At, B0); PG8_MMA(1, 1, At, B1); PG8_BAR; PG8_SCHED;
            } else {
            PG8_LDB(B0, 0, 0); PG8_SCHED; PG8_LDA(At, 0, 0); PG8_STAGE(PG8_SA(1, 1), a1 + hstep, voffA);
            PG8_WAIT_L(8); PG8_BAR; PG8_WAIT_L(0); PG8_MMA(0, 0, At, B0); PG8_BAR; PG8_SCHED;
            PG8_LDB(B1, 0, 1); PG8_STAGE(PG8_SB(0, 0), b2, voffB);
            PG8_BAR; PG8_WAIT_L(0); PG8_MMA(0, 1, At, B1); PG8_BAR;
            PG8_LDA(At, 0, 1); PG8_STAGE(PG8_SA(0, 0), a2, voffA);
            PG8_BAR; PG8_WAIT_L(0); PG8_MMA(1, 0, At, B0); PG8_BAR; PG8_SCHED;
            PG8_STAGE(PG8_SB(0, 1), b2 + hstep, voffB);
            PG8_WAIT_V(6); PG8_BAR; PG8_MMA(1, 1, At, B1); PG8_BAR;
            PG8_LDB(B0, 1, 0); PG8_SCHED; PG8_LDA(At, 1, 0); PG8_STAGE(PG8_SA(0, 1), a2 + hstep, voffA);
            PG8_WAIT_L(8); PG8_BAR; PG8_WAIT_L(0); PG8_MMA(0, 0, At, B0); PG8_BAR; PG8_SCHED;
            PG8_LDB(B1, 1, 1); PG8_STAGE(PG8_SB(1, 0), b3, voffB);
            PG8_BAR; PG8_WAIT_L(0); PG8_MMA(0, 1, At, B1); PG8_BAR;
            PG8_LDA(At, 1, 1); PG8_STAGE(PG8_SA(1, 0), a3, voffA);
            PG8_BAR; PG8_WAIT_L(0); PG8_MMA(1, 0, At, B0); PG8_BAR; PG8_SCHED;
            PG8_STAGE(PG8_SB(1, 1), b3 + hstep, voffB);
            PG8_WAIT_V(6); PG8_BAR; PG8_MMA(1, 1, At, B1); PG8_BAR;
            }
        }
        if constexpr (ALIGN_EPI) { if (wr == 0) PG8_BAR; }
        if constexpr (!Epi::AFTER_DRAIN) { E(acc, cur, wr, wc, fr, fq); S.done(cur); }
        if (!has_next) break;
#pragma unroll
        for (int a = 0; a < 2; ++a)
#pragma unroll
            for (int b = 0; b < 2; ++b)
#pragma unroll
                for (int m = 0; m < 4; ++m)
#pragma unroll
                    for (int n = 0; n < 2; ++n) acc[a][b][m][n] = (f32x4){0.f, 0.f, 0.f, 0.f};
        cur = nxt; cA = nA; cB = nB; ++ui;
        if constexpr (ALIGN_EPI) { if (wr == 1) PG8_BAR; }
    }
    PG8_WAIT_V(0);
    if constexpr (!ALIGN_EPI) { if (wr == 0) PG8_BAR; }
    PG8_BAR;
    if constexpr (Epi::AFTER_DRAIN) { E.fused(acc, cur, wr, wc, fr, fq, lds, wid, lane); S.done(cur); }
#undef PG8_SA
#undef PG8_SB
#undef PG8_STAGE
#undef PG8_LDA
#undef PG8_LDB
#undef PG8_MMA
#undef PG8_WAIT_V
#undef PG8_WAIT_L
#undef PG8_BAR
#undef PG8_SCHED
}
struct HalfOrder {
    int nM, nN, nwg, G, c;
    __host__ __device__ void init(int M, int N, int G_, int c_) { nM = M / HALF; nN = N / BM; nwg = nM * nN; G = G_; c = c_; }
    __host__ __device__ bool next(int i, Unit& u) const {
        const long L = (long)i * G + c; if (L >= nwg) return false;
        int wgid = (int)L; { const int q = nwg / NXCD, r = nwg % NXCD, xcd = wgid % NXCD, off = wgid / NXCD; wgid = (xcd < r ? xcd * (q + 1) : r * (q + 1) + (xcd - r) * q) + off; }
        const int nig = WGM * nN, gid = wgid / nig, fm = gid * WGM, gsz = (nM - fm) < WGM ? (nM - fm) : WGM;
        u.pm = fm + ((wgid % nig) % gsz); u.pn = (wgid % nig) / gsz; return true;
    }
    __device__ __forceinline__ int arow(int pm) const { return pm * HALF; }
};
struct HalfOrderMix : HalfOrder {
    __host__ __device__ bool next(int i, Unit& u) const { if (!HalfOrder::next(i, u)) return false; u.pm = (u.pm + 32 * i) % nM; return true; }
};
constexpr int PH_STG = 3 * HTB;
template <class Epi, class Sched, bool MMA_FIRST>
__device__ __forceinline__ void gemm_phase_h_impl(PG8_LAS unsigned char* lds, const Gemm g, const Sched& S, const Epi& E) {
    int tid_ = threadIdx.x; asm volatile("" : "+v"(tid_));
    const int tid = tid_, wid = __builtin_amdgcn_readfirstlane(tid >> 6), lane = tid & 63, wr = wid >> 2, wc = wid & 3, fr = lane & 15, fq = lane >> 4;
    const int K = g.K, nt = K / BK;
    unsigned voffA[2], voffB[2];
#pragma unroll
    for (int i = 0; i < 2; ++i) { int R, C; stage_rc(tid * 16 + i * 8192, R, C); const int Rb = Epi::PERM ? ((R & ~31) + perm32(R & 31)) : R;
        voffA[i] = (unsigned)(R * K + C) * 2u; voffB[i] = (unsigned)(Rb * K + C) * 2u; }
    const size_t kstep = (size_t)(BK * 2), hstep = (size_t)HALF * K * 2, tstepB = 2 * hstep;
    const unsigned ldsw = (unsigned)wid * 1024u;
    const int aoff = lds_byte(wr * 64 + fr, fq * 8), boff = lds_byte(wc * 32 + fr, fq * 8);
#define PH_STAGE(bufoff, gbase, voff) do { _Pragma("unroll") for (int _i = 0; _i < 2; ++_i) \
        __builtin_amdgcn_global_load_lds((const unsigned*)((const char*)(gbase) + (voff)[_i]), (PG8_LAS unsigned*)(lds + (bufoff) + ldsw + _i * 8192), 16, 0, 0); } while (0)
#define PH_STAGE3(so, ga, gb) do { PH_STAGE((so), ga, voffA); PH_STAGE((so) + HTB, gb, voffB); PH_STAGE((so) + 2 * HTB, (gb) + hstep, voffB); } while (0)
#define PH_LDALL(so, At, B0, B1) do { \
        _Pragma("unroll") for (int n = 0; n < 2; ++n) _Pragma("unroll") for (int k = 0; k < 2; ++k) B0[n][k] = *(const PG8_LAS bf16x8*)(lds + (so) + HTB + boff + n * 2048 + k * 1024); \
        _Pragma("unroll") for (int n = 0; n < 2; ++n) _Pragma("unroll") for (int k = 0; k < 2; ++k) B1[n][k] = *(const PG8_LAS bf16x8*)(lds + (so) + 2 * HTB + boff + n * 2048 + k * 1024); \
        _Pragma("unroll") for (int m = 0; m < 4; ++m) _Pragma("unroll") for (int k = 0; k < 2; ++k) At[m][k] = *(const PG8_LAS bf16x8*)(lds + (so) + aoff + m * 2048 + k * 1024); } while (0)
#define PH_MMA(bj, At, Bt) do { _Pragma("unroll") for (int m = 0; m < 4; ++m) _Pragma("unroll") for (int n = 0; n < 2; ++n) _Pragma("unroll") for (int k = 0; k < 2; ++k) \
        acc[0][bj][m][n] = __builtin_amdgcn_mfma_f32_16x16x32_bf16(Bt[n][k], At[m][k], acc[0][bj][m][n], 0, 0, 0); } while (0)
#define PH_SYNC6() do { __builtin_amdgcn_s_waitcnt(0x0076); asm volatile("" ::: "memory"); __builtin_amdgcn_s_barrier(); __builtin_amdgcn_sched_barrier(0); } while (0)
#define PH_SYNC0() do { __builtin_amdgcn_s_waitcnt(0x0070); asm volatile("" ::: "memory"); __builtin_amdgcn_s_barrier(); __builtin_amdgcn_sched_barrier(0); } while (0)
    Unit cur, nxt; int ui = 0;
    if (!S.next(0, cur)) return;
    f32x4 acc[1][2][4][2];
#pragma unroll
    for (int b = 0; b < 2; ++b)
#pragma unroll
        for (int m = 0; m < 4; ++m)
#pragma unroll
            for (int n = 0; n < 2; ++n) acc[0][b][m][n] = (f32x4){0.f, 0.f, 0.f, 0.f};
    bf16x8 Xa[4][2], Xb0[2][2], Xb1[2][2], Ya[4][2], Yb0[2][2], Yb1[2][2];
    const char* cA = (const char*)g.A + (size_t)S.arow(cur.pm) * (size_t)K * 2; const char* cB = (const char*)g.Bt + (size_t)cur.pn * tstepB;
    typename Epi::Pre pre; E.pre(cur, wr, wc, fr, fq, pre);
    int s0 = 0, s1 = PH_STG, s2 = 2 * PH_STG;
    PH_STAGE3(s0, cA, cB); PH_STAGE3(s1, cA + kstep, cB + kstep); PH_STAGE3(s2, cA + 2 * kstep, cB + 2 * kstep);
    PH_SYNC6();
    PH_LDALL(s0, Xa, Xb0, Xb1);
    __builtin_amdgcn_s_waitcnt(0xC07F);
    for (;;) {
        const bool has_next = S.next(ui + 1, nxt);
        const char* nA = has_next ? (const char*)g.A + (size_t)S.arow(nxt.pm) * (size_t)K * 2 : cA; const char* nB = has_next ? (const char*)g.Bt + (size_t)nxt.pn * tstepB : cB;
        for (int t = 0; t < nt; t += 2) {
            const int t3 = t + 3, t4 = t + 4;
            const char* a3 = t3 < nt ? cA + (size_t)t3 * kstep : nA + (size_t)(t3 - nt) * kstep; const char* b3 = t3 < nt ? cB + (size_t)t3 * kstep : nB + (size_t)(t3 - nt) * kstep;
            const char* a4 = t4 < nt ? cA + (size_t)t4 * kstep : nA + (size_t)(t4 - nt) * kstep; const char* b4 = t4 < nt ? cB + (size_t)t4 * kstep : nB + (size_t)(t4 - nt) * kstep;
            if constexpr (!MMA_FIRST) {
                PH_SYNC6();
                PH_STAGE3(s0, a3, b3);
                PH_LDALL(s1, Ya, Yb0, Yb1);
                __builtin_amdgcn_sched_barrier(0);
                __builtin_amdgcn_s_setprio(1); PH_MMA(0, Xa, Xb0); PH_MMA(1, Xa, Xb1); __builtin_amdgcn_s_setprio(0);
                PH_SYNC6();
                PH_STAGE3(s1, a4, b4);
                PH_LDALL(s2, Xa, Xb0, Xb1);
                __builtin_amdgcn_sched_barrier(0);
                __builtin_amdgcn_s_setprio(1); PH_MMA(0, Ya, Yb0); PH_MMA(1, Ya, Yb1); __builtin_amdgcn_s_setprio(0);
            } else {
                PH_SYNC6();
                __builtin_amdgcn_s_setprio(1); PH_MMA(0, Xa, Xb0); __builtin_amdgcn_s_setprio(0);
                __builtin_amdgcn_sched_barrier(0);
                PH_STAGE3(s0, a3, b3);
                PH_LDALL(s1, Ya, Yb0, Yb1);
                __builtin_amdgcn_sched_barrier(0);
                __builtin_amdgcn_s_setprio(1); PH_MMA(1, Xa, Xb1); __builtin_amdgcn_s_setprio(0);
                PH_SYNC6();
                __builtin_amdgcn_s_setprio(1); PH_MMA(0, Ya, Yb0); __builtin_amdgcn_s_setprio(0);
                __builtin_amdgcn_sched_barrier(0);
                PH_STAGE3(s1, a4, b4);
                PH_LDALL(s2, Xa, Xb0, Xb1);
                __builtin_amdgcn_sched_barrier(0);
                __builtin_amdgcn_s_setprio(1); PH_MMA(1, Ya, Yb1); __builtin_amdgcn_s_setprio(0);
            }
            { const int o0 = s0, o1 = s1; s0 = s2; s1 = o0; s2 = o1; }
        }
        E(acc, cur, wr, wc, fr, fq, pre);
        if (!has_next) break;
#pragma unroll
        for (int b = 0; b < 2; ++b)
#pragma unroll
            for (int m = 0; m < 4; ++m)
#pragma unroll
                for (int n = 0; n < 2; ++n) acc[0][b][m][n] = (f32x4){0.f, 0.f, 0.f, 0.f};
        cur = nxt; cA = nA; cB = nB; ++ui;
        E.pre(cur, wr, wc, fr, fq, pre);
    }
    PH_SYNC0();
#undef PH_STAGE
#undef PH_STAGE3
#undef PH_LDALL
#undef PH_MMA
#undef PH_SYNC6
#undef PH_SYNC0
}
template <class Epi, class Sched>
__device__ __forceinline__ void gemm_phase_h(PG8_LAS unsigned char* lds, const Gemm g, const Sched& S, const Epi& E) {
    if (__builtin_amdgcn_readfirstlane(threadIdx.x >> 8) == 0) gemm_phase_h_impl<Epi, Sched, false>(lds, g, S, E);
    else gemm_phase_h_impl<Epi, Sched, true>(lds, g, S, E);
}
}
#define XB_TMO      128
#define XB_XCNT(j)  (256  + 64 * (j))
#define XB_XSUB(j)  (1280 + 64 * (j))
#define XB_XGEN(j)  (2304 + 64 * (j))
#define XB_TOP      3328
#define XB_TOPGEN   3392
#define XCD_BAR_WORDS 3456
#define XB_SPIN_CAP (1u << 18)

__device__ __forceinline__ unsigned xb_ld(unsigned* p)              { return __hip_atomic_load(p, __ATOMIC_RELAXED, __HIP_MEMORY_SCOPE_AGENT); }
__device__ __forceinline__ unsigned xb_add(unsigned* p, unsigned v) { return __hip_atomic_fetch_add(p, v, __ATOMIC_RELAXED, __HIP_MEMORY_SCOPE_AGENT); }
__device__ __forceinline__ unsigned xb_xcc_id() { return (unsigned)__builtin_amdgcn_s_getreg((3 << 11) | 20) & 0xFu; }
#define XB_SPIN(cond, bar) do { unsigned _sp = 0; while (cond) { __builtin_amdgcn_s_sleep(1); \
    if ((++_sp & 255u) == 0u) { if (xb_ld(&(bar)[XB_TMO])) break; if (_sp > XB_SPIN_CAP) { atomicAdd(&(bar)[XB_TMO], 1u); break; } } } } while (0)

struct XcdBarrier {
    unsigned* bar; unsigned x;
    volatile LAS unsigned* st;
};

__device__ __forceinline__ XcdBarrier xcd_barrier_post(unsigned* bar, volatile LAS unsigned* st) {
    XcdBarrier b; b.bar = bar; b.x = xb_xcc_id(); b.st = st;
    if (threadIdx.x == 0) (void)xb_add(&bar[XB_XCNT(b.x)], 1u);
    return b;
}
__device__ __forceinline__ void xcd_barrier_complete(unsigned* bar, unsigned x, unsigned& nloc, unsigned& nx) {
    const unsigned G = gridDim.x * gridDim.y * gridDim.z;
    unsigned sum, cnt, mine, sp = 0u;
    for (;;) {
        sum = 0u; cnt = 0u; mine = 0u;
#pragma unroll
        for (unsigned j = 0; j < 16; ++j) { const unsigned c = xb_ld(&bar[XB_XCNT(j)]); sum += c; cnt += (c > 0u) ? 1u : 0u; mine = (j == x) ? c : mine; }
        if (sum == G) break;
        __builtin_amdgcn_s_sleep(1);
        if ((++sp & 255u) == 0u) { if (xb_ld(&bar[XB_TMO])) break; if (sp > XB_SPIN_CAP) { atomicAdd(&bar[XB_TMO], 1u); break; } }
    }
    nloc = mine > 0u ? mine : 1u; nx = cnt > 0u ? cnt : 1u;
}

__device__ __forceinline__ void xcd_barrier(const XcdBarrier& b) {
    asm volatile("s_waitcnt vmcnt(0)" ::: "memory");
    __syncthreads();
    if (threadIdx.x == 0) {
        unsigned* bar = b.bar;
        __builtin_amdgcn_s_waitcnt(0);
        unsigned nloc = b.st[0], nx = b.st[1];
        if (nloc == 0u) { xcd_barrier_complete(bar, b.x, nloc, nx); b.st[0] = nloc; b.st[1] = nx; }
        const unsigned old = xb_add(&bar[XB_XSUB(b.x)], 1u);
        const unsigned gen = old / nloc;
        if (old + 1u == (gen + 1u) * nloc) {
            __builtin_amdgcn_fence(__ATOMIC_RELEASE, "agent");
            asm volatile("s_waitcnt vmcnt(0)" ::: "memory");
            const unsigned og = xb_add(&bar[XB_TOP], 1u);
            const unsigned tg = og / nx;
            if (og + 1u == (tg + 1u) * nx) xb_add(&bar[XB_TOPGEN], 1u);
            else XB_SPIN(xb_ld(&bar[XB_TOPGEN]) == tg, bar);
            __builtin_amdgcn_fence(__ATOMIC_ACQUIRE, "agent");
            xb_add(&bar[XB_XGEN(b.x)], 1u);
            asm volatile("s_waitcnt vmcnt(0)" ::: "memory");
        } else {
            XB_SPIN(xb_ld(&bar[XB_XGEN(b.x)]) == gen, bar);
            __builtin_amdgcn_fence(__ATOMIC_ACQUIRE, "agent");
            asm volatile("s_waitcnt vmcnt(0)" ::: "memory");
        }
    }
    __syncthreads();
}
typedef unsigned short bf16_t;
typedef unsigned v4u __attribute__((ext_vector_type(4)));
typedef float f32x4 __attribute__((ext_vector_type(4)));
constexpr int D = 1024, NTOK = 8192, NCTX = 4096, DIN = 3072, DFF = 2816, DUP = 5632, NMOD = 6144;
constexpr float EPS = 1e-6f;
constexpr size_t MiB = 1u << 20;
constexpr size_t WS_BAR = 0, BAR_BYTES = 65536;
constexpr size_t WS_LAM = 64 * 1024, WS_ROPE = 72 * 1024, WS_KMAX = 80 * 1024, WS_MOD = 128 * 1024, WS_BIAS1 = 320 * 1024, WS_BIAS2 = 400 * 1024, WS_ROWSS = 576 * 1024;
constexpr int RS_STRIDE = 8704;
constexpr size_t WS_WIN = 1 * MiB, WS_WOUT = 13 * MiB, WS_WUP = 17 * MiB, WS_WDN = 39 * MiB;
constexpr size_t WS_XA = 50 * MiB, WS_ACT = 68 * MiB, WS_U = 112 * MiB;
constexpr size_t WS_BG = 112 * MiB, WS_P = 120 * MiB, WS_Q = 160 * MiB, WS_K = 168 * MiB, WS_V = 177 * MiB, WS_A2 = 186 * MiB;
constexpr size_t WS_XR = 202 * MiB;
constexpr size_t OUT_NK = 8388608, OUT_NV = 12582912;
constexpr int RING_BYTES = 147456, MISC_OFF = RING_BYTES, EDGE_OFF = RING_BYTES + 1024, LDS_BYTES = 159744;
constexpr int NWAVES = 8;

__device__ __forceinline__ float bf2f(bf16_t v) { return __uint_as_float(((unsigned)v) << 16); }
__device__ __forceinline__ unsigned f2bf(float f) { unsigned u = __float_as_uint(f); return (u + 0x7fffu + ((u >> 16) & 1u)) >> 16; }
__device__ __forceinline__ unsigned pk2(float lo, float hi) { return f2bf(lo) | (f2bf(hi) << 16); }
__device__ __forceinline__ int grp_of(int r) { return r < NCTX ? 0 : 1 + ((r - NCTX) >> 11); }
__device__ __forceinline__ int krow_of(int r) { return r < NCTX ? r : NCTX + ((r - NCTX) >> 11) * 2304 + 256 + ((r - NCTX) & 2047); }
__device__ __forceinline__ float silu_f(float x) { return x / (1.f + expf(-x)); }
__device__ __forceinline__ float wave_sum(float v) {
#pragma unroll
    for (int o = 1; o < 64; o <<= 1) v += __shfl_xor(v, o);
    return v;
}
__device__ __forceinline__ float wave_max(float v) {
#pragma unroll
    for (int o = 1; o < 64; o <<= 1) v = fmaxf(v, __shfl_xor(v, o));
    return v;
}
#define LDS_WAIT() asm volatile("s_waitcnt lgkmcnt(0)" ::: "memory")

struct Args { const float* in[24]; float* out; unsigned char* ws; };
struct KA {
    __device__ __forceinline__ const float* operator[](int i) const { const __attribute__((address_space(4))) unsigned char* k = (const __attribute__((address_space(4))) unsigned char*)__builtin_amdgcn_kernarg_segment_ptr(); asm volatile("" : "+s"(k)); return ((const float* const __attribute__((address_space(4)))*)k)[i]; }
};
struct AV {
    KA in;
    __device__ __forceinline__ float* out_() const { return (float*)in[24]; }
    __device__ __forceinline__ unsigned char* ws_() const { return (unsigned char*)in[25]; }
};

__device__ __forceinline__ void p0_transpose_load(f32x4 (&wv)[8], const float* W, int N, int item, int lane) {
    const int nblk = N / 32, kb = item / nblk, nb = item % nblk, k0 = 64 * kb, n0 = 32 * nb;
#pragma unroll
    for (int i = 0; i < 8; ++i) wv[i] = __builtin_nontemporal_load((const f32x4*)&W[(size_t)(k0 + i * 8 + (lane >> 3)) * N + n0 + (lane & 7) * 4]);
}
template <int MAP> __device__ __forceinline__ void p0_transpose_item(const f32x4 (&wv)[8], int K, int N, bf16_t* WT, LAS float* scr, int item, int lane) {
    const int nblk = N / 32, kb = item / nblk, nb = item % nblk, k0 = 64 * kb, n0 = 32 * nb;
#pragma unroll
    for (int i = 0; i < 8; ++i) { LAS float* d = scr + (i * 8 + (lane >> 3)) * 33 + (lane & 7) * 4; d[0] = wv[i][0]; d[1] = wv[i][1]; d[2] = wv[i][2]; d[3] = wv[i][3]; }
    LDS_WAIT(); asm volatile("" ::: "memory");
    const int c = lane & 7;
#pragma unroll
    for (int j = 0; j < 4; ++j) { const int n = (lane >> 3) + 8 * j; const LAS float* s = scr + (8 * c) * 33 + n;
        v4u o; o.x = pk2(s[0 * 33], s[1 * 33]); o.y = pk2(s[2 * 33], s[3 * 33]); o.z = pk2(s[4 * 33], s[5 * 33]); o.w = pk2(s[6 * 33], s[7 * 33]);
        int prow = n0 + n; if (MAP == 1) { const int bj = prow / DFF, j = prow - bj * DFF; prow = (j >> 7) * 256 + bj * 128 + (j & 127); }
        if (MAP == 2) { if (prow < 1024) { const int w = prow & 255, d = w & 63; prow = (prow & ~255) + (d >> 5) * 128 + (w >> 6) * 32 + (d & 31); }
                        else if (prow >= 2048) { const int x = prow >= 2560, j = prow - (x ? 2560 : 2048); prow = (8 + (j >> 7)) * 256 + x * 128 + (j & 127); } }
        *(v4u*)(WT + (size_t)prow * K + k0 + 8 * c) = o; }
    LDS_WAIT(); asm volatile("" ::: "memory");
}

__device__ __forceinline__ void kmax_update(unsigned* p, float v) { atomicMax(p, __float_as_uint(v)); }
namespace pg8 {
template <int AI> struct EpiInProj {
    static constexpr bool PERM = false, AFTER_DRAIN = false;
    struct Pre {}; __device__ __forceinline__ void pre(const Unit&, int, int, int, int, Pre&) const {}
    int l; const float* qg; const float* kg; const float* rope; bf16_t* Q; bf16_t* K; bf16_t* V; bf16_t* BG; bf16_t* P; float* out; unsigned* kmax; const float* rowss; const float* bias;
    __device__ __forceinline__ void operator()(f32x4 (&acc)[AI][2][4][2], const Unit& u, int wr, int wc, int fr_, int fq_, const Pre&) const {
        int fr = fr_, fq = fq_; asm volatile("" : "+v"(fr), "+v"(fq));
        const int r0 = u.pm * (AI * HALF), pn = u.pn; const bool ctx = r0 < 4096;
        const int seqb = ctx ? 0 : (r0 - 4096) >> 11;
        { f32x4 bv[2][2];
#pragma unroll
          for (int bj = 0; bj < 2; ++bj)
#pragma unroll
              for (int n = 0; n < 2; ++n) bv[bj][n] = *(const f32x4*)(bias + (size_t)(ctx ? 0 : 1 + seqb) * 3072 + pn * BM + bj * HALF + wc * 32 + n * 16 + 4 * fq);
#pragma unroll
          for (int ai = 0; ai < AI; ++ai)
#pragma unroll
              for (int m = 0; m < 4; ++m) { const float rs = rsqrtf(rowss[r0 + ai * HALF + wr * 64 + m * 16 + fr] * (1.f / 1024.f) + EPS);
#pragma unroll
                  for (int bj = 0; bj < 2; ++bj)
#pragma unroll
                      for (int n = 0; n < 2; ++n) acc[ai][bj][m][n] = acc[ai][bj][m][n] * rs + bv[bj][n]; } }
        if (pn < 4) {
            const bool isk = pn >= 2; const float* gw = isk ? kg : qg;
            f32x4 g[2][2];
#pragma unroll
            for (int bj = 0; bj < 2; ++bj)
#pragma unroll
                for (int n = 0; n < 2; ++n) g[bj][n] = *(const f32x4*)(gw + 32 * bj + 16 * n + 4 * fq);
            const int cb = 256 * (pn & 1) + 64 * wc + 4 * fq;
            float kmx = 0.f;
            f32x4 rcs[AI][4][2][2];
            if (!ctx) {
#pragma unroll
                for (int ai = 0; ai < AI; ++ai)
#pragma unroll
                    for (int m = 0; m < 4; ++m) { const int t = (r0 + ai * HALF + wr * 64 + m * 16 + fr - 4096) & 2047;
#pragma unroll
                        for (int bj = 0; bj < 2; ++bj) { const int pos = bj ? (t & 63) : (t >> 6);
                            rcs[ai][m][bj][0] = *(const f32x4*)(rope + (pos * 16 + 4 * fq) * 2); rcs[ai][m][bj][1] = *(const f32x4*)(rope + (pos * 16 + 4 * fq) * 2 + 4); } } }
#pragma unroll
            for (int ai = 0; ai < AI; ++ai)
#pragma unroll
                for (int m = 0; m < 4; ++m) { const int row = r0 + ai * HALF + wr * 64 + m * 16 + fr;
                    float ss = 0.f;
#pragma unroll
                    for (int bj = 0; bj < 2; ++bj)
#pragma unroll
                        for (int n = 0; n < 2; ++n) { const f32x4 z = acc[ai][bj][m][n]; ss += (z[0] * z[0] + z[1] * z[1]) + (z[2] * z[2] + z[3] * z[3]); }
                    ss += __shfl_xor(ss, 16); ss += __shfl_xor(ss, 32);
                    const float rs = rsqrtf(ss * (1.f / 64.f) + EPS);
                    f32x4 v[2][2]; float kss = 0.f;
#pragma unroll
                    for (int bj = 0; bj < 2; ++bj)
#pragma unroll
                        for (int n = 0; n < 2; ++n) { v[bj][n] = acc[ai][bj][m][n] * rs * g[bj][n]; const f32x4 q = v[bj][n]; kss += (q[0] * q[0] + q[1] * q[1]) + (q[2] * q[2] + q[3] * q[3]); }
                    if (isk) { kss += __shfl_xor(kss, 16); kss += __shfl_xor(kss, 32); kmx = fmaxf(kmx, kss);
                        if (ctx) { float* nk = out + OUT_NK + ((size_t)((row >> 8) * 2 + l) * 256 + (row & 255)) * 512 + cb;
#pragma unroll
                            for (int bj = 0; bj < 2; ++bj)
#pragma unroll
                                for (int n = 0; n < 2; ++n) __builtin_nontemporal_store(v[bj][n], (f32x4*)(nk + 32 * bj + 16 * n)); } }
                    if (!ctx) {
#pragma unroll
                        for (int bj = 0; bj < 2; ++bj) {
                            const f32x4 cs0 = rcs[ai][m][bj][0], cs1 = rcs[ai][m][bj][1];
                            const float c[4] = {cs0[0], cs0[2], cs1[0], cs1[2]}, s[4] = {cs0[1], cs0[3], cs1[1], cs1[3]};
                            const f32x4 x1 = v[bj][0], x2 = v[bj][1];
#pragma unroll
                            for (int e = 0; e < 4; ++e) { v[bj][0][e] = x1[e] * c[e] - x2[e] * s[e]; v[bj][1][e] = x2[e] * c[e] + x1[e] * s[e]; } } }
                    const int krow = ctx ? row : 4096 + seqb * 2304 + 256 + ((row - 4096) & 2047);
                    bf16_t* dst = (isk ? K + (size_t)krow * 512 : Q + (size_t)row * 512) + cb;
#pragma unroll
                    for (int bj = 0; bj < 2; ++bj) { const u32x4 w = pair16(v[bj][0], v[bj][1]); *(u32x4*)(dst - 4 * fq + 32 * bj + pair16_col(fq)) = w; }
                }
            if (isk) {
                kmx = fmaxf(kmx, __shfl_xor(kmx, 1)); kmx = fmaxf(kmx, __shfl_xor(kmx, 2)); kmx = fmaxf(kmx, __shfl_xor(kmx, 4)); kmx = fmaxf(kmx, __shfl_xor(kmx, 8));
                if (fr == 0 && fq == 0) kmax_update(kmax + l * 256 + (ctx ? (r0 >> 8) : 16 + seqb) * 8 + 4 * (pn & 1) + wc, kmx);
            }
        } else if (pn < 8) {
            const bool isv = pn < 6; const int cb = 256 * (pn & 1) + wc * 32 + 4 * fq;
#pragma unroll
            for (int ai = 0; ai < AI; ++ai)
#pragma unroll
                for (int m = 0; m < 4; ++m) { const int row = r0 + ai * HALF + wr * 64 + m * 16 + fr;
                    const int krow = ctx ? row : 4096 + seqb * 2304 + 256 + ((row - 4096) & 2047);
                    bf16_t* dst = (isv ? V + (size_t)krow * 512 : BG + (size_t)row * 512) + cb;
                    float* nv = out + OUT_NV + ((size_t)((row >> 8) * 2 + l) * 256 + (row & 255)) * 512 + cb;
#pragma unroll
                    for (int bj = 0; bj < 2; ++bj) { const u32x4 w = pair16(acc[ai][bj][m][0], acc[ai][bj][m][1]); *(u32x4*)(dst - 4 * fq + 128 * bj + pair16_col(fq)) = w;
#pragma unroll
                        for (int n = 0; n < 2; ++n) if (isv && ctx) __builtin_nontemporal_store(acc[ai][bj][m][n], (f32x4*)(nv + 128 * bj + 16 * n)); } }
        } else {
            const int cb = 128 * (pn - 8) + wc * 32 + 4 * fq;
#pragma unroll
            for (int ai = 0; ai < AI; ++ai)
#pragma unroll
                for (int m = 0; m < 4; ++m) { const int row = r0 + ai * HALF + wr * 64 + m * 16 + fr;
                    { const u32x4 w = pair16(acc[ai][0][m][0] * acc[ai][1][m][0], acc[ai][0][m][1] * acc[ai][1][m][1]); *(u32x4*)(P + (size_t)row * 512 + cb - 4 * fq + pair16_col(fq)) = w; } }
        }
    }
};
}
__device__ __forceinline__ void phase_prologue(const AV a, LAS unsigned char* lds, int tid, int lane, int wave, int vcu, int G) {
    unsigned char* ws = a.ws_();
    const int bx = blockIdx.x;
    for (int it = bx; it < 256; it += G) {
        LAS float* sc = (LAS float*)lds;
        LAS float* red = (LAS float*)(lds + 12288);
        __syncthreads();
        for (int i = tid; i < 1024; i += 512) { sc[i] = silu_f(a.in[5][i]); sc[1024 + i] = silu_f(a.in[4][i]); sc[2048 + i] = silu_f(a.in[4][1024 + i]); }
        __syncthreads();
        const int l = it >> 7, n0 = (it & 127) * 48, ln = lane < 48 ? lane : 47;
        const float* wp = a.in[6] + (size_t)l * D * NMOD + (size_t)(wave * 128) * NMOD + n0 + ln;
        float a0 = 0.f, a1 = 0.f, a2 = 0.f;
#pragma unroll 32
        for (int k = 0; k < 128; ++k) { const float wv = __builtin_nontemporal_load(&wp[(size_t)k * NMOD]); const int kk = wave * 128 + k; a0 += sc[kk] * wv; a1 += sc[1024 + kk] * wv; a2 += sc[2048 + kk] * wv; }
        red[(wave * 3 + 0) * 64 + lane] = a0; red[(wave * 3 + 1) * 64 + lane] = a1; red[(wave * 3 + 2) * 64 + lane] = a2;
        __syncthreads();
        if (wave < 3 && lane < 48) {
            float s = 0.f;
#pragma unroll
            for (int w = 0; w < 8; ++w) s += red[(w * 3 + wave) * 64 + lane];
            ((float*)(ws + WS_MOD))[((size_t)l * 3 + wave) * NMOD + n0 + lane] = s + a.in[7][l * NMOD + n0 + lane];
        }
        __syncthreads();
    }
    if (bx == G - 1) {
        if (tid < 2) {
            const int l = tid; float s1 = 0.f, s2 = 0.f;
            for (int i = 0; i < 64; ++i) { s1 += a.in[12][l * 64 + i] * a.in[13][l * 64 + i]; s2 += a.in[14][l * 64 + i] * a.in[15][l * 64 + i]; }
            const float lam_init = 0.8f - 0.6f * expf(-0.3f * (float)l);
            float* lam = (float*)(ws + WS_LAM);
            lam[l * 2 + 0] = expf(s1) - expf(s2) + lam_init; lam[l * 2 + 1] = lam_init;
        }
        for (int i = tid; i < 512; i += 512) ((unsigned*)(ws + WS_KMAX))[i] = 0u;
        float* rope = (float*)(ws + WS_ROPE);
        for (int i = tid; i < 64 * 16; i += 512) {
            const int pos = i >> 4, f = i & 15;
            const float ang = (float)pos * powf(10000.f, -(float)f / 16.f);
            rope[i * 2 + 0] = cosf(ang); rope[i * 2 + 1] = sinf(ang);
        }
    }
    for (int i = bx * 512 + tid; i < 4 * RS_STRIDE; i += G * 512) ((float*)(ws + WS_ROWSS))[i] = 0.f;
    LAS float* scr = (LAS float*)(lds + wave * 16384);
    const int gw = vcu * NWAVES + wave, NGW = G * NWAVES;
    constexpr int I_IN = (D / 64) * (DIN / 32), I_OUT = (D / 64) * (D / 32), I_UP = (D / 64) * (DUP / 32), I_DN = (DFF / 64) * (D / 32), I_L = I_IN + I_OUT + I_UP + I_DN;
    auto fetch = [&](f32x4 (&wv)[8], int it) {
        const int l = it / I_L; int r = it % I_L;
        if (r < I_IN) { p0_transpose_load(wv, a.in[9] + (size_t)l * D * DIN, DIN, r, lane); return; } r -= I_IN;
        if (r < I_OUT) { p0_transpose_load(wv, a.in[19] + (size_t)l * D * D, D, r, lane); return; } r -= I_OUT;
        if (r < I_UP) { p0_transpose_load(wv, a.in[21] + (size_t)l * D * DUP, DUP, r, lane); return; } r -= I_UP;
        p0_transpose_load(wv, a.in[23] + (size_t)l * DFF * D, D, r, lane);
    };
    f32x4 nx[8];
    if (gw < 2 * I_L) fetch(nx, gw);
    for (int it = gw; it < 2 * I_L; it += NGW) {
        f32x4 cu[8];
#pragma unroll
        for (int i = 0; i < 8; ++i) cu[i] = nx[i];
        if (it + NGW < 2 * I_L) fetch(nx, it + NGW);
        const int l = it / I_L; int r = it % I_L;
        if (r < I_IN) { p0_transpose_item<2>(cu, D, DIN, (bf16_t*)(ws + WS_WIN) + (size_t)l * DIN * D, scr, r, lane); continue; } r -= I_IN;
        if (r < I_OUT) { p0_transpose_item<0>(cu, D, D, (bf16_t*)(ws + WS_WOUT) + (size_t)l * D * D, scr, r, lane); continue; } r -= I_OUT;
        if (r < I_UP) { p0_transpose_item<1>(cu, D, DUP, (bf16_t*)(ws + WS_WUP) + (size_t)l * DUP * D, scr, r, lane); continue; } r -= I_UP;
        p0_transpose_item<0>(cu, DFF, D, (bf16_t*)(ws + WS_WDN) + (size_t)l * D * DFF, scr, r, lane);
    }
}

__device__ __forceinline__ void phase_prep(const AV a, int lane, int gw, int NGW) {
    unsigned char* ws = a.ws_();
    constexpr int CH = 9, NCI = (DIN + CH - 1) / CH, NCU = (DUP + CH - 1) / CH, NCL = NCI + NCU;
    for (int c = gw; c < 2 * NCL; c += NGW) {
        const int l = c / NCL; int cc = c - l * NCL;
        const bool up = cc >= NCI; if (up) cc -= NCI;
        const int nrows = up ? DUP : DIN, q0 = cc * CH;
        const bf16_t* wt = (up ? (const bf16_t*)(ws + WS_WUP) + (size_t)l * DUP * D : (const bf16_t*)(ws + WS_WIN) + (size_t)l * DIN * D) + lane * 16;
        const float* sh = (const float*)(ws + WS_MOD) + (size_t)l * 3 * NMOD + (up ? 3 * D : 0) + lane * 16;
        v4u w[CH][2];
#pragma unroll
        for (int i = 0; i < CH; ++i) { const int q = q0 + i < nrows ? q0 + i : nrows - 1; w[i][0] = *(const v4u*)(wt + (size_t)q * D); w[i][1] = *(const v4u*)(wt + (size_t)q * D + 8); }
        f32x4 t[3][4];
#pragma unroll
        for (int g = 0; g < 3; ++g)
#pragma unroll
            for (int j = 0; j < 4; ++j) t[g][j] = *(const f32x4*)(sh + (size_t)g * NMOD + 4 * j);
        float* dst = (up ? (float*)(ws + WS_BIAS2) + (size_t)l * 3 * DUP : (float*)(ws + WS_BIAS1) + (size_t)l * 3 * DIN) + (size_t)(lane < 3 ? lane : 0) * nrows;
#pragma unroll
        for (int i = 0; i < CH; ++i) {
            float wv[16];
#pragma unroll
            for (int j = 0; j < 4; ++j) { wv[2 * j] = __uint_as_float(w[i][0][j] << 16); wv[2 * j + 1] = __uint_as_float(w[i][0][j] & 0xffff0000u); wv[8 + 2 * j] = __uint_as_float(w[i][1][j] << 16); wv[8 + 2 * j + 1] = __uint_as_float(w[i][1][j] & 0xffff0000u); }
            float s3[3];
#pragma unroll
            for (int g = 0; g < 3; ++g) { float acc = 0.f;
#pragma unroll
                for (int j = 0; j < 4; ++j) acc += t[g][j][0] * wv[4 * j] + t[g][j][1] * wv[4 * j + 1] + t[g][j][2] * wv[4 * j + 2] + t[g][j][3] * wv[4 * j + 3];
                s3[g] = wave_sum(acc); }
            if (lane < 3 && q0 + i < nrows) dst[q0 + i] = lane == 0 ? s3[0] : (lane == 1 ? s3[1] : s3[2]);
        }
    }
    const float* g1 = a.in[8];
    f32x4 gn[4];
#pragma unroll
    for (int j = 0; j < 4; ++j) gn[j] = *(const f32x4*)(g1 + 4 * lane + 256 * j);
    for (int rb = gw; rb < NTOK; rb += 4 * NGW) {
        f32x4 v[4][4], mul[4][4];
#pragma unroll
        for (int i = 0; i < 4; ++i) { const int r = rb + i * NGW < NTOK ? rb + i * NGW : rb;
            const float* x = r < NCTX ? a.in[0] + (size_t)r * D : a.in[1] + (size_t)(r - NCTX) * D;
            const float* sc = (const float*)(ws + WS_MOD) + (size_t)grp_of(r) * NMOD + D;
#pragma unroll
            for (int j = 0; j < 4; ++j) { v[i][j] = __builtin_nontemporal_load((const f32x4*)(x + 4 * lane + 256 * j)); mul[i][j] = *(const f32x4*)(sc + 4 * lane + 256 * j); } }
#pragma unroll
        for (int i = 0; i < 4; ++i)
#pragma unroll
            for (int j = 0; j < 4; ++j) { asm volatile("" : "+v"(v[i][j]), "+v"(mul[i][j])); }
#pragma unroll
        for (int i = 0; i < 4; ++i) { const int r = rb + i * NGW;
            if (r < NTOK) {
                float ss = 0.f;
#pragma unroll
                for (int j = 0; j < 4; ++j) ss += (v[i][j].x * v[i][j].x + v[i][j].y * v[i][j].y) + (v[i][j].z * v[i][j].z + v[i][j].w * v[i][j].w);
                ss = wave_sum(ss);
                if (lane == 0) ((float*)(ws + WS_ROWSS))[r] = ss;
                bf16_t* o = (bf16_t*)(ws + WS_XA) + (size_t)r * D;
#pragma unroll
                for (int j = 0; j < 4; ++j) { const int c = 4 * lane + 256 * j;
                    const f32x4 y = v[i][j] * gn[j] * (mul[i][j] + 1.f);
                    uint2 w2; w2.x = pk2(y.x, y.y); w2.y = pk2(y.z, y.w); *(uint2*)(o + c) = w2; } } }
    }
}

__device__ __forceinline__ void step_cache_rows(const AV a, int l, int lane, int gw, int NGW) {
    unsigned char* ws = a.ws_();
    for (int i = gw; i < 512; i += NGW) {
        const int b = i >> 8, pos = i & 255;
        const float* ck = a.in[2] + ((size_t)(b * 2 + l) * 256 + pos) * 512 + lane * 8;
        const float* cv = a.in[3] + ((size_t)(b * 2 + l) * 256 + pos) * 512 + lane * 8;
        const f32x4 k0 = __builtin_nontemporal_load((const f32x4*)ck), k1 = __builtin_nontemporal_load((const f32x4*)(ck + 4)), v0 = __builtin_nontemporal_load((const f32x4*)cv), v1 = __builtin_nontemporal_load((const f32x4*)(cv + 4));
        v4u kw, vw; kw.x = pk2(k0.x, k0.y); kw.y = pk2(k0.z, k0.w); kw.z = pk2(k1.x, k1.y); kw.w = pk2(k1.z, k1.w);
        vw.x = pk2(v0.x, v0.y); vw.y = pk2(v0.z, v0.w); vw.z = pk2(v1.x, v1.y); vw.w = pk2(v1.z, v1.w);
        float kss = (k0.x * k0.x + k0.y * k0.y) + (k0.z * k0.z + k0.w * k0.w) + (k1.x * k1.x + k1.y * k1.y) + (k1.z * k1.z + k1.w * k1.w);
        kss += __shfl_xor(kss, 1); kss += __shfl_xor(kss, 2); kss += __shfl_xor(kss, 4);
        if ((lane & 7) == 0) kmax_update((unsigned*)(ws + WS_KMAX) + l * 256 + (16 + b) * 8 + (lane >> 3), kss);
        *(v4u*)((bf16_t*)(ws + WS_K) + (size_t)(NCTX + b * 2304 + pos) * 512 + lane * 8) = kw;
        *(v4u*)((bf16_t*)(ws + WS_V) + (size_t)(NCTX + b * 2304 + pos) * 512 + lane * 8) = vw;
    }
}
__device__ __forceinline__ void convbr_rows(const AV a, int l, int rbase, int lane, int wave) {
    unsigned char* ws = a.ws_();
    const float* cw = a.in[17] + l * 3 * 512 + lane * 8;
    const float* gn = a.in[18] + l * 512 + lane * 8;
    v4u pc[2], pu[2], pd[2], bg[2];
    const v4u z4 = {0u, 0u, 0u, 0u};
#pragma unroll
    for (int k = 0; k < 2; ++k) { const int r = rbase + 2 * wave + k;
        const bool lat = r >= NCTX; const int t = lat ? ((r - NCTX) & 2047) : (r & 255), len = lat ? 2048 : 256;
        const bf16_t* P = (const bf16_t*)(ws + WS_P) + (size_t)r * 512 + lane * 8;
        pc[k] = *(const v4u*)P; pu[k] = (t > 0) ? *(const v4u*)(P - 512) : z4; pd[k] = (t < len - 1) ? *(const v4u*)(P + 512) : z4;
        bg[k] = *(const v4u*)((const bf16_t*)(ws + WS_BG) + (size_t)r * 512 + lane * 8); }
    float w0[8], w1[8], w2[8], g[8];
#pragma unroll
    for (int j = 0; j < 8; ++j) { w0[j] = cw[j]; w1[j] = cw[512 + j]; w2[j] = cw[1024 + j]; g[j] = gn[j]; }
#pragma unroll
    for (int k = 0; k < 2; ++k) { const int r = rbase + 2 * wave + k;
        float y[8]; float ss = 0.f;
#pragma unroll
        for (int j = 0; j < 8; ++j) {
            const float c = __uint_as_float((j & 1) ? (pc[k][j >> 1] & 0xffff0000u) : (pc[k][j >> 1] << 16)), u = __uint_as_float((j & 1) ? (pu[k][j >> 1] & 0xffff0000u) : (pu[k][j >> 1] << 16));
            const float d = __uint_as_float((j & 1) ? (pd[k][j >> 1] & 0xffff0000u) : (pd[k][j >> 1] << 16)), b = __uint_as_float((j & 1) ? (bg[k][j >> 1] & 0xffff0000u) : (bg[k][j >> 1] << 16));
            y[j] = b * (w0[j] * u + w1[j] * c + w2[j] * d); ss += y[j] * y[j]; }
        ss = wave_sum(ss);
        const float rs = rsqrtf(ss * (1.f / 512.f) + EPS);
        v4u o; o.x = pk2(y[0] * rs * g[0], y[1] * rs * g[1]); o.y = pk2(y[2] * rs * g[2], y[3] * rs * g[3]); o.z = pk2(y[4] * rs * g[4], y[5] * rs * g[5]); o.w = pk2(y[6] * rs * g[6], y[7] * rs * g[7]);
        *(v4u*)((bf16_t*)(ws + WS_A2) + (size_t)r * D + 512 + lane * 8) = o; }
}

namespace att {
using bf16x8 = __attribute__((ext_vector_type(8))) short;
using s16x4  = __attribute__((ext_vector_type(4))) short;
using f32x16 = __attribute__((ext_vector_type(16))) float;
using u32x4  = __attribute__((ext_vector_type(4))) unsigned;
#define KSWZ(row, colB) ((row) * 256 + ((colB) ^ (((row) & 7) << 4)))
#define SBAR() __builtin_amdgcn_sched_barrier(0)
__device__ __forceinline__ int crow(int r, int hi) { return (r & 3) + 8 * (r >> 2) + 4 * hi; }
__device__ __forceinline__ unsigned cvtpk(float lo, float hi) { unsigned r; asm volatile("v_cvt_pk_bf16_f32 %0, %1, %2" : "=v"(r) : "v"(lo), "v"(hi)); return r; }
__device__ __forceinline__ int v_st(int k, int c) { const int kk = (k & ~0xC) | ((k & 4) << 1) | ((k & 8) >> 1); return ((kk >> 3) * 4 + (c >> 5)) * 512 + ((kk & 7) * 32 + (c & 31)) * 2; }
__device__ __forceinline__ int v_rd_base(int lane) { return ((lane & 3) << 3) | (((lane >> 2) & 3) << 6) | (((lane >> 4) & 1) << 5) | (((lane >> 5) & 1) << 8); }
constexpr int v_rd_off(int d0, int ks, int half) { return d0 * 512 + ks * 4096 + half * 2048; }
template <int OFF> __device__ __forceinline__ s16x4 tr_read(int vb) {
    s16x4 r; asm volatile("ds_read_b64_tr_b16 %0, %1 offset:%2" : "=&v"(r) : "v"(vb), "i"(OFF) : "memory"); return r;
}
template <int D0> __device__ __forceinline__ void pv_one(f32x16& od, int vb, bf16x8 pa0, bf16x8 pa1, bf16x8 pa2, bf16x8 pa3) {
    const s16x4 l0 = tr_read<v_rd_off(D0, 0, 0)>(vb), h0 = tr_read<v_rd_off(D0, 0, 1)>(vb), l1 = tr_read<v_rd_off(D0, 1, 0)>(vb), h1 = tr_read<v_rd_off(D0, 1, 1)>(vb);
    const s16x4 l2 = tr_read<v_rd_off(D0, 2, 0)>(vb), h2 = tr_read<v_rd_off(D0, 2, 1)>(vb), l3 = tr_read<v_rd_off(D0, 3, 0)>(vb), h3 = tr_read<v_rd_off(D0, 3, 1)>(vb);
    asm volatile("s_waitcnt lgkmcnt(0)" ::: "memory"); SBAR();
#define PK(L, H) (bf16x8){L[0], L[1], L[2], L[3], H[0], H[1], H[2], H[3]}
    od = __builtin_amdgcn_mfma_f32_32x32x16_bf16(pa0, PK(l0, h0), od, 0, 0, 0);
    od = __builtin_amdgcn_mfma_f32_32x32x16_bf16(pa1, PK(l1, h1), od, 0, 0, 0);
    od = __builtin_amdgcn_mfma_f32_32x32x16_bf16(pa2, PK(l2, h2), od, 0, 0, 0);
    od = __builtin_amdgcn_mfma_f32_32x32x16_bf16(pa3, PK(l3, h3), od, 0, 0, 0);
#undef PK
}
constexpr int LDS_STAGE = 65536, LDS_V = 0, LDS_K = 32768, LDS_P1 = 0, LDS_OT = 65536, LDS_WS = 98304;
constexpr float SC_C = 0.125f * 1.4426950408889634f;

__device__ __forceinline__ void attn_unit(const bf16_t* __restrict__ Qb, const bf16_t* __restrict__ Kh, const bf16_t* __restrict__ Vh, int nk, float kmax2_0, float kmax2_1,
                                          float lam, float lam_init, const float* __restrict__ subg, bf16_t* __restrict__ A2o, LAS unsigned char* lds, const AV a, int layer, int conv_rbase) {
    int tid_ = threadIdx.x; asm volatile("" : "+v"(tid_));
    const int tid = tid_, wave = __builtin_amdgcn_readfirstlane(tid >> 6), lane = tid & 63, r32 = lane & 31, hi = lane >> 5;
    const int qg = wave & 1, s = (wave >> 1) & 1, kh = wave >> 2;
    LAS float* li_l = (LAS float*)(lds + LDS_WS + wave * 256);
    LAS float* lpart = (LAS float*)(lds + LDS_WS + 2048);
    LAS float* OT = (LAS float*)(lds + LDS_OT);
    LAS float* P1 = (LAS float*)(lds + LDS_P1);
    bf16x8 qr[4];
    const bf16_t* Qw = Qb + (size_t)(qg * 32 + r32) * 512 + s * 64 + hi * 8;
    float qss = 0.f;
#pragma unroll
    for (int d0 = 0; d0 < 4; ++d0) { qr[d0] = *(const bf16x8*)(Qw + d0 * 16);
#pragma unroll
        for (int j = 0; j < 8; ++j) { const float q = __uint_as_float(((unsigned)(unsigned short)qr[d0][j]) << 16); qss += q * q; } }
    qss += __shfl_xor(qss, 32);
    const float mC = -(sqrtf(qss * (s ? kmax2_1 : kmax2_0)) * 1.01f) * SC_C;
    const int vb0 = (int)(unsigned)(size_t)(lds + LDS_V) + v_rd_base(lane) + kh * 16384;
    unsigned soff[8];
#pragma unroll
    for (int i = 0; i < 8; ++i) { const int q = (wave & 1) * 8 + i;
        if (wave < 4) { const int sub = 2 * q + (lane >> 5), kk = (sub >> 2) * 8 + ((lane & 31) >> 2), c = (sub & 3) * 32 + (lane & 3) * 8;
                        const int k = (kk & ~0xC) | ((kk & 4) << 1) | ((kk & 8) >> 1); soff[i] = (unsigned)(k * 1024 + c * 2); }
        else          { const int row = q * 4 + (lane >> 4), ch = (lane & 15) ^ (row & 15); soff[i] = (unsigned)(row * 1024 + ch * 16); } }
    const char* gsrc = (const char*)(wave < 4 ? Vh : Kh) + (size_t)(((wave >> 1) & 1) * 64) * 1024;
    const int ldst = (wave >> 1) * 16384 + (wave & 1) * 8192;
#define STAGE(b, key0) do { const char* g_ = gsrc + (size_t)(key0) * 1024; _Pragma("unroll") for (int i = 0; i < 8; ++i) \
        __builtin_amdgcn_global_load_lds((const unsigned*)(g_ + soff[i]), (LAS unsigned*)(lds + (b) * LDS_STAGE + ldst + i * 1024), 16, 0, 0); } while (0)
#define LBARV() do { asm volatile("s_waitcnt vmcnt(0) lgkmcnt(0)" ::: "memory"); __builtin_amdgcn_s_barrier(); asm volatile("" ::: "memory"); } while (0)
    f32x16 o0 = {}, o1 = {}, o2 = {}, o3 = {}; float l = 0.f;
    const int NS = nk >> 7;
    STAGE(0, 0);
    convbr_rows(a, layer, conv_rbase, lane, wave);
    LBARV();
    const int ldsb = (int)(unsigned)(size_t)lds;
    int kad0, kad1, kad2, kad3;
    { const int sw = (r32 & 15) << 4, rb = ldsb + LDS_K + kh * 16384 + r32 * 256, cs = s * 128 + hi * 16;
      kad0 = rb + ((cs + 0 * 32) ^ sw); kad1 = rb + ((cs + 1 * 32) ^ sw); kad2 = rb + ((cs + 2 * 32) ^ sw); kad3 = rb + ((cs + 3 * 32) ^ sw); }
#define KRD(dst, addr, OFF) asm volatile("ds_read_b128 %0, %1 offset:%2" : "=&v"(dst) : "v"(addr), "i"(OFF) : "memory")
#define LWAIT(N) do { asm volatile("s_waitcnt lgkmcnt(%0)" :: "n"(N) : "memory"); SBAR(); } while (0)
#define EXPP(P, r) do { P[r] = __builtin_amdgcn_exp2f(fmaf(P[r], SC_C, mC)); ps += P[r]; } while (0)
#define VGRP(D0, H, G) do { G##a = tr_read<v_rd_off(D0, 2 * (H), 0)>(vb); G##b = tr_read<v_rd_off(D0, 2 * (H), 1)>(vb); G##c = tr_read<v_rd_off(D0, 2 * (H) + 1, 0)>(vb); G##d = tr_read<v_rd_off(D0, 2 * (H) + 1, 1)>(vb); } while (0)
#define PK(L, H) (bf16x8){L[0], L[1], L[2], L[3], H[0], H[1], H[2], H[3]}
#define PK4(P, BASE, OUT) do { unsigned a0 = cvtpk(P[BASE + 0], P[BASE + 1]), a1 = cvtpk(P[BASE + 2], P[BASE + 3]);   \
    unsigned b0_ = cvtpk(P[BASE + 4], P[BASE + 5]), b1_ = cvtpk(P[BASE + 6], P[BASE + 7]);                              \
    auto r0 = __builtin_amdgcn_permlane32_swap(a0, b0_, false, false); auto r1 = __builtin_amdgcn_permlane32_swap(a1, b1_, false, false); \
    u32x4 w = {r0[0], r1[0], r0[1], r1[1]}; OUT = *reinterpret_cast<bf16x8*>(&w); } while (0)
#define MM(A, B, C) C = __builtin_amdgcn_mfma_f32_32x32x16_bf16(A, B, C, 0, 0, 0)
    for (int j = 0; j < NS; ++j) {
        const int b = j & 1, so = b * LDS_STAGE, vb = vb0 + so;
        bf16x8 kA0, kA1, kA2, kA3, kB0, kB1, kB2, kB3;
        s16x4 g0a, g0b, g0c, g0d, g1a, g1b, g1c, g1d, g2a, g2b, g2c, g2d, g3a, g3b, g3c, g3d;
        KRD(kA0, kad0 + so, 0); KRD(kA1, kad1 + so, 0); KRD(kA2, kad2 + so, 0); KRD(kA3, kad3 + so, 0);
        KRD(kB0, kad0 + so, 8192); KRD(kB1, kad1 + so, 8192); KRD(kB2, kad2 + so, 8192); KRD(kB3, kad3 + so, 8192);
        VGRP(0, 0, g0);
        if (j + 1 < NS) STAGE(b ^ 1, (j + 1) * 128);
        f32x16 p0 = {}, p1 = {};
        float ps = 0.f;
        SBAR();
        LWAIT(11); MM(kA0, qr[0], p0); SBAR();
        LWAIT(10); MM(kA1, qr[1], p0); SBAR();
        LWAIT(9);  MM(kA2, qr[2], p0); SBAR();
        LWAIT(8);  MM(kA3, qr[3], p0); SBAR();
        LWAIT(7);  MM(kB0, qr[0], p1); SBAR();
        LWAIT(6);  MM(kB1, qr[1], p1); SBAR(); EXPP(p0, 0); EXPP(p0, 1); EXPP(p0, 2); EXPP(p0, 3); SBAR();
        LWAIT(5);  MM(kB2, qr[2], p1); SBAR(); EXPP(p0, 4); EXPP(p0, 5); EXPP(p0, 6); EXPP(p0, 7); SBAR();
        LWAIT(4);  MM(kB3, qr[3], p1); SBAR(); EXPP(p0, 8); EXPP(p0, 9); EXPP(p0, 10); EXPP(p0, 11); SBAR();
        VGRP(1, 0, g1);
        EXPP(p0, 12); EXPP(p0, 13); EXPP(p0, 14); EXPP(p0, 15);
        bf16x8 pa0, pa1, pa2, pa3;
        PK4(p0, 0, pa0); PK4(p0, 8, pa1);
        SBAR();
        LWAIT(4); MM(pa0, PK(g0a, g0b), o0); SBAR(); EXPP(p1, 0); EXPP(p1, 1); SBAR();
        MM(pa1, PK(g0c, g0d), o0); SBAR(); EXPP(p1, 2); EXPP(p1, 3); SBAR();
        VGRP(2, 0, g2); SBAR();
        LWAIT(4); MM(pa0, PK(g1a, g1b), o1); SBAR(); EXPP(p1, 4); EXPP(p1, 5); SBAR();
        MM(pa1, PK(g1c, g1d), o1); SBAR(); EXPP(p1, 6); EXPP(p1, 7); SBAR();
        VGRP(3, 0, g3); SBAR();
        LWAIT(4); MM(pa0, PK(g2a, g2b), o2); SBAR(); EXPP(p1, 8); EXPP(p1, 9); SBAR();
        MM(pa1, PK(g2c, g2d), o2); SBAR(); EXPP(p1, 10); EXPP(p1, 11); SBAR();
        VGRP(0, 1, g0); SBAR();
        LWAIT(4); MM(pa0, PK(g3a, g3b), o3); SBAR(); EXPP(p1, 12); EXPP(p1, 13); SBAR();
        MM(pa1, PK(g3c, g3d), o3); SBAR(); EXPP(p1, 14); EXPP(p1, 15); SBAR();
        VGRP(1, 1, g1);
        l += ps;
        PK4(p1, 0, pa2); PK4(p1, 8, pa3);
        SBAR();
        LWAIT(4); MM(pa2, PK(g0a, g0b), o0); MM(pa3, PK(g0c, g0d), o0); SBAR();
        VGRP(2, 1, g2); SBAR();
        LWAIT(4); MM(pa2, PK(g1a, g1b), o1); MM(pa3, PK(g1c, g1d), o1); SBAR();
        VGRP(3, 1, g3); SBAR();
        LWAIT(4); MM(pa2, PK(g2a, g2b), o2); MM(pa3, PK(g2c, g2d), o2); SBAR();
        LWAIT(0); MM(pa2, PK(g3a, g3b), o3); MM(pa3, PK(g3c, g3d), o3); SBAR();
        LBARV();
    }
#undef KRD
#undef LWAIT
#undef EXPP
#undef VGRP
#undef PK
#undef PK4
#undef MM
#undef STAGE
#undef LBARV
#define SLOAD(x)
#define SWRITE(x)
#undef SLOAD
#undef SWRITE
    l += __shfl_xor(l, 32);
    const int pair = qg * 2 + s;
    if (kh == 1) {
#pragma unroll
        for (int r = 0; r < 16; ++r) { P1[((pair * 4 + 0) * 16 + r) * 64 + lane] = o0[r]; P1[((pair * 4 + 1) * 16 + r) * 64 + lane] = o1[r];
                                       P1[((pair * 4 + 2) * 16 + r) * 64 + lane] = o2[r]; P1[((pair * 4 + 3) * 16 + r) * 64 + lane] = o3[r]; }
        if (hi == 0) lpart[pair * 32 + r32] = l;
    }
    __syncthreads();
    float rli[16];
    if (kh == 0) {
#pragma unroll
        for (int r = 0; r < 16; ++r) { o0[r] += P1[((pair * 4 + 0) * 16 + r) * 64 + lane]; o1[r] += P1[((pair * 4 + 1) * 16 + r) * 64 + lane];
                                       o2[r] += P1[((pair * 4 + 2) * 16 + r) * 64 + lane]; o3[r] += P1[((pair * 4 + 3) * 16 + r) * 64 + lane]; }
        l += lpart[pair * 32 + r32];
        if (hi == 0) li_l[r32] = l;
        asm volatile("s_waitcnt lgkmcnt(0)" ::: "memory");
        const float wgt = s ? lam : 1.f;
#pragma unroll
        for (int r = 0; r < 16; ++r) rli[r] = wgt / li_l[crow(r, hi)];
        if (s == 1) {
#pragma unroll
            for (int r = 0; r < 16; ++r) { LAS float* row = OT + (qg * 32 + crow(r, hi)) * 128 + r32; row[0] = o0[r] * rli[r]; row[32] = o1[r] * rli[r]; row[64] = o2[r] * rli[r]; row[96] = o3[r] * rli[r]; }
        }
    }
    __syncthreads();
    if (kh == 0 && s == 0) {
#pragma unroll
        for (int r = 0; r < 16; ++r) { LAS float* row = OT + (qg * 32 + crow(r, hi)) * 128 + r32;
            row[0] = o0[r] * rli[r] - row[0]; row[32] = o1[r] * rli[r] - row[32]; row[64] = o2[r] * rli[r] - row[64]; row[96] = o3[r] * rli[r] - row[96]; }
    }
    __syncthreads();
    const float g0 = subg[2 * lane], g1 = subg[2 * lane + 1];
#pragma unroll
    for (int i = 0; i < 8; ++i) { const int row = wave * 8 + i;
        const float x0 = OT[row * 128 + 2 * lane], x1 = OT[row * 128 + 2 * lane + 1];
        const float ss = wave_sum(x0 * x0 + x1 * x1);
        const float rs = rsqrtf(ss * (1.f / 128.f) + EPS) * (1.f - lam_init);
        *(unsigned*)(A2o + (size_t)row * 1024 + 2 * lane) = pk2(x0 * rs * g0, x1 * rs * g1); }
    __syncthreads();
}
#undef KSWZ
#undef SBAR
}

__device__ __forceinline__ void phase_attn(const AV a, int l, LAS unsigned char* lds) {
    unsigned char* ws = a.ws_();
    const int G = gridDim.x;
    const float lam = ((const float*)(ws + WS_LAM))[l * 2], lam_init = ((const float*)(ws + WS_LAM))[l * 2 + 1];
    const float* kmax = (const float*)(ws + WS_KMAX) + l * 256;
    for (int it = blockIdx.x; it < 512; it += G) {
        int r0, kbase, nk, h, seq;
        if (it < 256) { const int b = it >> 7, qb = it & 31; h = (it >> 5) & 3; r0 = NCTX + b * 2048 + qb * 64; kbase = NCTX + b * 2304; nk = 2304; seq = 16 + b; }
        else { const int i2 = it - 256, b = i2 >> 4, qb = i2 & 3; h = (i2 >> 2) & 3; r0 = b * 256 + qb * 64; kbase = b * 256; nk = 256; seq = b; }
        att::attn_unit((const bf16_t*)(ws + WS_Q) + (size_t)r0 * 512 + h * 128, (const bf16_t*)(ws + WS_K) + (size_t)kbase * 512 + h * 128,
                       (const bf16_t*)(ws + WS_V) + (size_t)kbase * 512 + h * 128, nk, kmax[seq * 8 + h * 2], kmax[seq * 8 + h * 2 + 1],
                       lam, lam_init, a.in[16] + l * 128, (bf16_t*)(ws + WS_A2) + (size_t)r0 * D + h * 128, lds, a, l, r0 + 16 * h);
    }
}

template <int L>
__device__ __forceinline__ void layer_body(const AV a, LAS unsigned char* lds, const XcdBarrier& bar) {
    int tid_ = threadIdx.x; asm volatile("" : "+v"(tid_));
    const int lane = tid_ & 63, wave = __builtin_amdgcn_readfirstlane(tid_ >> 6);
    const int G = gridDim.x, bx = blockIdx.x;
    const int vcu = (G % 8 == 0) ? (bx % 8) * (G / 8) + bx / 8 : bx;
    const int gw = vcu * NWAVES + wave, NGW = G * NWAVES;
    constexpr int l = L;
    step_cache_rows(a, l, lane, gw, NGW);
    { unsigned char* ws = a.ws_();
      pg8::Gemm g{(const bf16_t*)(ws + WS_XA), (const bf16_t*)(ws + WS_WIN) + (size_t)l * DIN * D, NTOK, DIN, D}; pg8::HalfOrderMix S; S.init(NTOK, DIN, G, bx);
      pg8::EpiInProj<1> E{l, a.in[10] + l * 64, a.in[11] + l * 64, (const float*)(ws + WS_ROPE), (bf16_t*)(ws + WS_Q), (bf16_t*)(ws + WS_K), (bf16_t*)(ws + WS_V), (bf16_t*)(ws + WS_BG), (bf16_t*)(ws + WS_P), a.out_(), (unsigned*)(ws + WS_KMAX),
                        (const float*)(ws + WS_ROWSS) + (size_t)(l * 2) * RS_STRIDE, (const float*)(ws + WS_BIAS1) + (size_t)l * 3 * DIN};
      pg8::gemm_phase_h<pg8::EpiInProj<1>, pg8::HalfOrderMix>(lds, g, S, E);
    }
    xcd_barrier(bar);
    phase_attn(a, l, lds);
    xcd_barrier(bar);
    { unsigned char* ws = a.ws_(); const float* mod = (const float*)(ws + WS_MOD) + (size_t)l * 3 * NMOD;
      pg8::Gemm g{(const bf16_t*)(ws + WS_A2), (const bf16_t*)(ws + WS_WOUT) + (size_t)l * D * D, NTOK, D, D}; pg8::HalfOrder S; S.init(NTOK, D, G, bx);
      pg8::EpiRes<1, l == 0 ? 0 : 1, 1> E{a.in[0], a.in[1], (bf16_t*)(ws + WS_XR), nullptr, mod + 2 * D, (bf16_t*)(ws + WS_XA), a.in[20] + l * D, mod + 4 * D, (float*)(ws + WS_ROWSS) + (size_t)(l * 2 + 1) * RS_STRIDE};
      pg8::gemm_phase_h<pg8::EpiRes<1, l == 0 ? 0 : 1, 1>, pg8::HalfOrder>(lds, g, S, E);
    }
    xcd_barrier(bar);
    { unsigned char* ws = a.ws_();
      pg8::Gemm g{(const bf16_t*)(ws + WS_XA), (const bf16_t*)(ws + WS_WUP) + (size_t)l * DUP * D, 34 * 256, DUP, D}; pg8::OrderUp S; S.init(34 * 256, DUP, G, bx);
      pg8::EpiSwiglu E{a.in[22] + (size_t)l * 3 * DUP, (bf16_t*)(ws + WS_ACT), (LAS float*)(lds + EDGE_OFF), (const float*)(ws + WS_ROWSS) + (size_t)(l * 2 + 1) * RS_STRIDE, (const float*)(ws + WS_BIAS2) + (size_t)l * 3 * DUP};
      pg8::gemm_phase<pg8::EpiSwiglu, pg8::OrderUp, true, true>(lds, g, S, E);
    }
    xcd_barrier(bar);
    { unsigned char* ws = a.ws_(); const float* mod = (const float*)(ws + WS_MOD) + (size_t)l * 3 * NMOD;
      pg8::Gemm g{(const bf16_t*)(ws + WS_ACT), (const bf16_t*)(ws + WS_WDN) + (size_t)l * D * DFF, NTOK, D, DFF}; pg8::HalfOrder S; S.init(NTOK, D, G, bx);
      const float* modn = (const float*)(ws + WS_MOD) + (size_t)(l + 1) * 3 * NMOD;
      pg8::EpiRes<1, 1, l == 0 ? 1 : 0> E{nullptr, nullptr, (bf16_t*)(ws + WS_XR), a.out_(), mod + 5 * D, l == 0 ? (bf16_t*)(ws + WS_XA) : nullptr, a.in[8] + (l + 1) * D, modn + D, (float*)(ws + WS_ROWSS) + (size_t)((l + 1) * 2) * RS_STRIDE};
      pg8::gemm_phase_h<pg8::EpiRes<1, 1, l == 0 ? 1 : 0>, pg8::HalfOrder>(lds, g, S, E);
    }
}

__global__ void __launch_bounds__(512, 2) mk_fwd(Args args_unused) {
    const AV a{};
    extern __shared__ __attribute__((aligned(16))) unsigned char lds_raw[];
    LAS unsigned char* lds = (LAS unsigned char*)lds_raw;
    volatile LAS unsigned* MISC = (volatile LAS unsigned*)(lds + MISC_OFF);
    const int tid = threadIdx.x, lane = tid & 63, wave = __builtin_amdgcn_readfirstlane(tid >> 6);
    const int G = gridDim.x, bx = blockIdx.x;
    const int vcu = (G % 8 == 0) ? (bx % 8) * (G / 8) + bx / 8 : bx;
    const int gw = vcu * NWAVES + wave, NGW = G * NWAVES;
    unsigned char* ws = a.ws_();
    for (int u = tid; u < 64; u += 512) MISC[u] = 0u;
    __syncthreads();
    XcdBarrier bar = xcd_barrier_post((unsigned*)(ws + WS_BAR) + 4096, MISC + 8);

    phase_prologue(a, lds, tid, lane, wave, vcu, G);
    xcd_barrier(bar);
    { int t_ = threadIdx.x; asm volatile("" : "+v"(t_)); phase_prep(a, t_ & 63, vcu * NWAVES + __builtin_amdgcn_readfirstlane(t_ >> 6), G * NWAVES);
    }
    xcd_barrier(bar);
    layer_body<0>(a, lds, bar);
    xcd_barrier(bar);
    layer_body<1>(a, lds, bar);
}

extern "C" void kernel_launch(void* const* d_in, const int* in_sizes, int n_in, void* d_out, int out_size, void* d_ws, size_t ws_size, hipStream_t stream) {
    static int grid = 0;
    if (grid == 0) {
        int dev = 0, cus = 0, per_cu = 0;
        if (hipGetDevice(&dev) != hipSuccess || hipDeviceGetAttribute(&cus, hipDeviceAttributeMultiprocessorCount, dev) != hipSuccess) { fprintf(stderr, "kernel_launch: device query failed\n"); grid = -1; return; }
        if (hipFuncSetAttribute((const void*)mk_fwd, hipFuncAttributeMaxDynamicSharedMemorySize, LDS_BYTES) != hipSuccess) { fprintf(stderr, "kernel_launch: hipFuncSetAttribute failed\n"); grid = -1; return; }
        if (hipOccupancyMaxActiveBlocksPerMultiprocessor(&per_cu, (const void*)mk_fwd, NWAVES * 64, LDS_BYTES) != hipSuccess || per_cu < 1) { fprintf(stderr, "kernel_launch: occupancy query failed (%d)\n", per_cu); (void)hipGetLastError(); per_cu = 1; }
        if (per_cu > 1) per_cu = 1;
        grid = cus * per_cu;
    }
    if (grid < 0) return;
    (void)hipMemsetAsync((char*)d_ws + WS_BAR + 16384, 0, 16384, stream);
    Args a{};
    for (int i = 0; i < 24; ++i) a.in[i] = (const float*)d_in[i];
    a.out = (float*)d_out; a.ws = (unsigned char*)d_ws;
    void* args[] = {&a};
    hipError_t e = hipLaunchCooperativeKernel((const void*)mk_fwd, dim3(grid), dim3(NWAVES * 64), args, LDS_BYTES, stream);
    if (e != hipSuccess) fprintf(stderr, "kernel_launch: cooperative launch failed: %s (grid %d)\n", hipGetErrorString(e), grid);
}
```

```cpp
#include <hip/hip_runtime.h>
#include <hip/hip_cooperative_groups.h>
#include <cstdio>
#include <cstdint>
#include <math.h>
namespace cg = cooperative_groups;
#define GAS __attribute__((address_space(1)))
#define LAS __attribute__((address_space(3)))
namespace pg8 {
#define PG8_LAS __attribute__((address_space(3)))
typedef unsigned short bf16_t;
typedef short bf16x8 __attribute__((ext_vector_type(8)));
typedef float f32x4 __attribute__((ext_vector_type(4)));
typedef unsigned u32x4 __attribute__((ext_vector_type(4)));
constexpr int BM = 256, BK = 64, HALF = 128, HTB = HALF * BK * 2  , STAGE_BYTES = 8 * HTB, NXCD = 8, WGM = 8;

__host__ __device__ __forceinline__ int lds_byte(int r, int c) { const int st = (r >> 4) * 2 + (c >> 5), rr = r & 15, cc = c & 31, ob = rr * 64 + cc * 2; return st * 1024 + (ob ^ (((ob >> 9) & 1) << 5)); }
__host__ __device__ __forceinline__ void stage_rc(int b, int& R, int& C) { const int st = b / 1024, sb = b % 1024, swz = sb ^ (((sb >> 9) & 1) << 5); R = (st >> 1) * 16 + swz / 64; C = (st & 1) * 32 + (swz % 64) / 2; }
__host__ __device__ __forceinline__ int perm32(int rho) { const int n = rho >> 4, i = rho & 15; return 8 * (i >> 2) + 4 * n + (i & 3); }

struct Unit { int pm, pn; };
struct Gemm { const bf16_t* A; const bf16_t* Bt; int M, N, K; };

struct StaticOrder {
    int nM, nN, nwg, G, c;
    __host__ __device__ void init(int M, int N, int G_, int c_) { nM = M / BM; nN = N / BM; nwg = nM * nN; G = G_; c = c_; }
    __host__ __device__ bool next(int i, Unit& u) const {
        const long L = (long)i * G + c; if (L >= nwg) return false;
        int wgid = (int)L; { const int q = nwg / NXCD, r = nwg % NXCD, xcd = wgid % NXCD, off = wgid / NXCD; wgid = (xcd < r ? xcd * (q + 1) : r * (q + 1) + (xcd - r) * q) + off; }
        const int nig = WGM * nN, gid = wgid / nig, fm = gid * WGM, gsz = (nM - fm) < WGM ? (nM - fm) : WGM;
        u.pm = fm + ((wgid % nig) % gsz); u.pn = (wgid % nig) / gsz; return true;
    }
    __device__ __forceinline__ int arow(int pm) const { return pm * BM; }
    __device__ __forceinline__ void a_ready(const Unit&) const {}
    __device__ __forceinline__ void done(const Unit&) const {}
};
struct OrderUp : StaticOrder {
    __device__ __forceinline__ int arow(int pm) const { return pm < 16 ? pm * BM : 4096 + ((pm - 16) / 9) * 2048 + ((pm - 16) % 9) * 254 - 1; }
};

__device__ __forceinline__ unsigned cvt_pk_bf16(float lo, float hi) { unsigned r; asm volatile("v_cvt_pk_bf16_f32 %0, %1, %2" : "=v"(r) : "v"(lo), "v"(hi)); return r; }
__device__ __forceinline__ u32x4 pair16(f32x4 v0, f32x4 v1) {
    const unsigned ax = cvt_pk_bf16(v0[0], v0[1]), ay = cvt_pk_bf16(v0[2], v0[3]), bx = cvt_pk_bf16(v1[0], v1[1]), by = cvt_pk_bf16(v1[2], v1[3]);
    const auto rx = __builtin_amdgcn_permlane16_swap(ax, bx, false, false); const auto ry = __builtin_amdgcn_permlane16_swap(ay, by, false, false);
    return (u32x4){rx[0], ry[0], rx[1], ry[1]};
}
__device__ __forceinline__ int pair16_col(int fq) { return 16 * (fq & 1) + 8 * (fq >> 1); }
__device__ __forceinline__ void unpair16(u32x4 q, f32x4& v0, f32x4& v1) {
    const auto rx = __builtin_amdgcn_permlane16_swap(q[0], q[2], false, false); const auto ry = __builtin_amdgcn_permlane16_swap(q[1], q[3], false, false);
    v0 = (f32x4){__uint_as_float(rx[0] << 16), __uint_as_float(rx[0] & 0xffff0000u), __uint_as_float(ry[0] << 16), __uint_as_float(ry[0] & 0xffff0000u)};
    v1 = (f32x4){__uint_as_float(rx[1] << 16), __uint_as_float(rx[1] & 0xffff0000u), __uint_as_float(ry[1] << 16), __uint_as_float(ry[1] & 0xffff0000u)};
}
template <int AI, int XIN, int OUT> struct EpiRes {
    static constexpr bool PERM = false, AFTER_DRAIN = false;
    const float* xin0; const float* xin1; bf16_t* xr; float* out; const float* gate;
    bf16_t* xa; const float* gnext; const float* scnext; float* rowss;
    struct Pre { u32x4 q[XIN == 1 ? AI : 1][4][2]; };
    __device__ __forceinline__ void pre(const Unit& u, int wr, int wc, int fr, int fq, Pre& p) const {
        if (XIN == 1) { const int r0 = u.pm * (AI * HALF), colp = u.pn * BM + wc * 32 + pair16_col(fq);
#pragma unroll
            for (int ai = 0; ai < AI; ++ai)
#pragma unroll
                for (int m = 0; m < 4; ++m)
#pragma unroll
                    for (int bj = 0; bj < 2; ++bj) p.q[ai][m][bj] = *(const u32x4*)(xr + (size_t)(r0 + ai * HALF + wr * 64 + m * 16 + fr) * 1024 + colp + bj * HALF); }
    }
    __device__ __forceinline__ void operator()(const f32x4 (&acc)[AI][2][4][2], const Unit& u, int wr, int wc, int fr_, int fq_, const Pre& pre) const {
        int fr = fr_, fq = fq_; asm volatile("" : "+v"(fr), "+v"(fq));
        const int r0 = u.pm * (AI * HALF);
        const float* xb = (r0 < 4096) ? xin0 + (size_t)r0 * 1024 : xin1 + (size_t)(r0 - 4096) * 1024;
        const int grp = (r0 < 4096) ? 0 : 1 + ((r0 - 4096) >> 11);
        const int col0 = u.pn * BM + wc * 32 + 4 * fq, colp = u.pn * BM + wc * 32 + pair16_col(fq);
        f32x4 gv[2][2], gs[2][2];
#pragma unroll
        for (int bj = 0; bj < 2; ++bj)
#pragma unroll
            for (int n = 0; n < 2; ++n) { const int c = col0 + bj * HALF + n * 16; gv[bj][n] = *(const f32x4*)(gate + (size_t)grp * 6144 + c);
                if (xa) gs[bj][n] = *(const f32x4*)(gnext + c) * (*(const f32x4*)(scnext + (size_t)grp * 6144 + c) + 1.f); else gs[bj][n] = gv[bj][n]; }
#pragma unroll
        for (int ai = 0; ai < AI; ++ai)
#pragma unroll
            for (int m = 0; m < 4; ++m) { const int rl = ai * HALF + wr * 64 + m * 16 + fr; float ssq = 0.f;
#pragma unroll
                for (int bj = 0; bj < 2; ++bj) { f32x4 xv[2], o[2], yv[2];
                    if (XIN == 0) { xv[0] = *(const f32x4*)(xb + (size_t)rl * 1024 + col0 + bj * HALF); xv[1] = *(const f32x4*)(xb + (size_t)rl * 1024 + col0 + bj * HALF + 16); }
                    else unpair16(pre.q[ai][m][bj], xv[0], xv[1]);
#pragma unroll
                    for (int n = 0; n < 2; ++n) { o[n] = xv[n] + gv[bj][n] * acc[ai][bj][m][n];
                        if (OUT == 0) __builtin_nontemporal_store(o[n], (f32x4*)(out + (size_t)(r0 + rl) * 1024 + col0 + bj * HALF + n * 16));
                        if (xa) { ssq += (o[n][0] * o[n][0] + o[n][1] * o[n][1]) + (o[n][2] * o[n][2] + o[n][3] * o[n][3]); yv[n] = o[n] * gs[bj][n]; } }
                    if (OUT == 1) *(u32x4*)(xr + (size_t)(r0 + rl) * 1024 + colp + bj * HALF) = pair16(o[0], o[1]);
                    if (xa) *(u32x4*)(xa + (size_t)(r0 + rl) * 1024 + colp + bj * HALF) = pair16(yv[0], yv[1]); }
                if (xa) { ssq += __shfl_xor(ssq, 16); ssq += __shfl_xor(ssq, 32); if (fq == 0) atomicAdd(rowss + r0 + rl, ssq); } }
    }
};
typedef _Float16 h2_t __attribute__((ext_vector_type(2)));
template <int CTRL> __device__ __forceinline__ h2_t dpph(h2_t old, h2_t src) {
    return __builtin_bit_cast(h2_t, __builtin_amdgcn_update_dpp(__builtin_bit_cast(int, old), __builtin_bit_cast(int, src), CTRL, 0xf, 0xf, false)); }
__device__ __forceinline__ h2_t pkh(float a, float b) { return __builtin_bit_cast(h2_t, __builtin_amdgcn_cvt_pkrtz(a, b)); }
struct EpiSwiglu {
    static constexpr bool PERM = true, AFTER_DRAIN = false;
    const float* cw; bf16_t* act; PG8_LAS float* edge; const float* rowss; const float* bias;
    __device__ __forceinline__ void operator()(f32x4 (&acc)[2][2][4][2], const Unit& u, int wr, int wc, int fr_, int fq_) const {
        int fr = fr_, fq = fq_; asm volatile("" : "+v"(fr), "+v"(fq));
        int row0, vlo = 0, vhi = 256, olo = 0, ohi = 256;
        if (u.pm < 16) row0 = u.pm * 256;
        else { const int b = (u.pm - 16) / 9, i = (u.pm - 16) % 9, t0 = 254 * i - 1; row0 = 4096 + 2048 * b + t0; vlo = (i == 0) ? 1 : 0; vhi = (2048 - t0) < 256 ? (2048 - t0) : 256; olo = 1; ohi = vhi < 255 ? vhi : 255; }
        h2_t U[2][2][4][2][2];
        {
            const int grp = u.pm < 16 ? 0 : 1 + (u.pm - 16) / 9;
            const bool need_mask = vlo > 0 || vhi < 256;
            f32x4 bv[2][2];
#pragma unroll
            for (int bj = 0; bj < 2; ++bj)
#pragma unroll
                for (int n = 0; n < 2; ++n) bv[bj][n] = *(const f32x4*)(bias + (size_t)grp * 5632 + u.pn * BM + bj * HALF + wc * 32 + 8 * fq + 4 * n);
            if (!need_mask) {
#pragma unroll
                for (int ai = 0; ai < 2; ++ai)
#pragma unroll
                    for (int m = 0; m < 4; ++m) { const float rs = rsqrtf(rowss[row0 + ai * HALF + wr * 64 + m * 16 + fr] * (1.f / 1024.f) + 1e-6f);
#pragma unroll
                        for (int bj = 0; bj < 2; ++bj)
#pragma unroll
                            for (int n = 0; n < 2; ++n) { const f32x4 v = acc[ai][bj][m][n] * rs + bv[bj][n]; U[ai][bj][m][n][0] = pkh(v[0], v[1]); U[ai][bj][m][n][1] = pkh(v[2], v[3]); } }
            } else {
#pragma unroll
                for (int ai = 0; ai < 2; ++ai)
#pragma unroll
                    for (int m = 0; m < 4; ++m) { const int rho = ai * HALF + wr * 64 + m * 16 + fr; const bool ok = rho >= vlo && rho < vhi;
                        const float rs = rsqrtf(rowss[row0 + rho] * (1.f / 1024.f) + 1e-6f);
#pragma unroll
                        for (int bj = 0; bj < 2; ++bj)
#pragma unroll
                            for (int n = 0; n < 2; ++n) { f32x4 v = acc[ai][bj][m][n] * rs + bv[bj][n]; v[0] = ok ? v[0] : 0.f; v[1] = ok ? v[1] : 0.f; v[2] = ok ? v[2] : 0.f; v[3] = ok ? v[3] : 0.f;
                                U[ai][bj][m][n][0] = pkh(v[0], v[1]); U[ai][bj][m][n][1] = pkh(v[2], v[3]); } }
            }
        }
#pragma unroll
        for (int ai = 0; ai < 2; ++ai) { const int seg = ai * 2 + wr;
#pragma unroll
            for (int bj = 0; bj < 2; ++bj)
#pragma unroll
                for (int n = 0; n < 2; ++n) {
                    if (fr == 0)  { PG8_LAS h2_t* p = (PG8_LAS h2_t*)(edge + ((seg * 2 + 0) * 4 + wc) * 64 + (bj * 2 + n) * 16 + fq * 4); p[0] = U[ai][bj][0][n][0]; p[1] = U[ai][bj][0][n][1]; }
                    if (fr == 15) { PG8_LAS h2_t* p = (PG8_LAS h2_t*)(edge + ((seg * 2 + 1) * 4 + wc) * 64 + (bj * 2 + n) * 16 + fq * 4); p[0] = U[ai][bj][3][n][0]; p[1] = U[ai][bj][3][n][1]; } } }
        asm volatile("s_waitcnt lgkmcnt(0)" ::: "memory"); __builtin_amdgcn_s_barrier(); asm volatile("" ::: "memory");
        const int cj = u.pn * HALF + wc * 32 + 8 * fq;
        const h2_t zero2 = {(_Float16)0.f, (_Float16)0.f};
        uint2 keep[2][4];
#pragma unroll
        for (int n = 0; n < 2; ++n) {
            h2_t w[3][2][2];
#pragma unroll
            for (int tp = 0; tp < 3; ++tp)
#pragma unroll
                for (int bj = 0; bj < 2; ++bj) { const f32x4 wf = *(const f32x4*)(cw + tp * 5632 + bj * 2816 + cj + 4 * n); w[tp][bj][0] = pkh(wf[0], wf[1]); w[tp][bj][1] = pkh(wf[2], wf[3]); }
#pragma unroll
            for (int ai = 0; ai < 2; ++ai) { const int seg = ai * 2 + wr;
                h2_t above[2][2], below[2][2];
#pragma unroll
                for (int bj = 0; bj < 2; ++bj)
#pragma unroll
                    for (int p = 0; p < 2; ++p) {
                        above[bj][p] = seg > 0 ? ((const PG8_LAS h2_t*)(edge + (((seg - 1) * 2 + 1) * 4 + wc) * 64 + (bj * 2 + n) * 16 + fq * 4))[p] : zero2;
                        below[bj][p] = seg < 3 ? ((const PG8_LAS h2_t*)(edge + (((seg + 1) * 2 + 0) * 4 + wc) * 64 + (bj * 2 + n) * 16 + fq * 4))[p] : zero2; }
#pragma unroll
                for (int m = 0; m < 4; ++m) { const int rho = ai * HALF + wr * 64 + m * 16 + fr;
                    h2_t c[2][2];
#pragma unroll
                    for (int bj = 0; bj < 2; ++bj)
#pragma unroll
                        for (int p = 0; p < 2; ++p) { const h2_t cur = U[ai][bj][m][n][p];
                            const h2_t oldu = (m > 0) ? dpph<0x121>(U[ai][bj][m > 0 ? m - 1 : 0][n][p], U[ai][bj][m > 0 ? m - 1 : 0][n][p]) : above[bj][p];
                            const h2_t up = dpph<0x111>(oldu, cur);
                            const h2_t oldd = (m < 3) ? dpph<0x12F>(U[ai][bj][m < 3 ? m + 1 : 3][n][p], U[ai][bj][m < 3 ? m + 1 : 3][n][p]) : below[bj][p];
                            const h2_t dn = dpph<0x101>(oldd, cur);
                            c[bj][p] = w[1][bj][p] * cur + w[0][bj][p] * up + w[2][bj][p] * dn; }
                    float r[4];
#pragma unroll
                    for (int e = 0; e < 4; ++e) { const float x = (float)c[0][e >> 1][e & 1], y = (float)c[1][e >> 1][e & 1];
                        r[e] = x * __builtin_amdgcn_rcpf(1.f + __builtin_amdgcn_exp2f(-1.4426950408889634f * x)) * y; }
                    uint2 o; o.x = cvt_pk_bf16(r[0], r[1]); o.y = cvt_pk_bf16(r[2], r[3]);
                    if (n == 0) keep[ai][m] = o;
                    else { u32x4 q; q.x = keep[ai][m].x; q.y = keep[ai][m].y; q.z = o.x; q.w = o.y;
                        if (rho >= olo && rho < ohi) *(u32x4*)(act + (size_t)(row0 + rho) * 2816 + cj) = q; } }
            }
        }
    }
};
template <class Epi, class Sched, bool ALIGN_EPI = false, bool SP2 = false>
__device__ __forceinline__ void gemm_phase(PG8_LAS unsigned char* lds, const Gemm g, const Sched& S, const Epi& E) {
    int tid_ = threadIdx.x; asm volatile("" : "+v"(tid_));
    const int tid = tid_, wid = __builtin_amdgcn_readfirstlane(tid >> 6), lane = tid & 63, wr = wid >> 2, wc = wid & 3, fr = lane & 15, fq = lane >> 4;
    const int K = g.K, nt = K / BK;
    unsigned voffA[2], voffB[2];
#pragma unroll
    for (int i = 0; i < 2; ++i) { int R, C; stage_rc(tid * 16 + i * 8192, R, C); const int Rb = Epi::PERM ? ((R & ~31) + perm32(R & 31)) : R;
        voffA[i] = (unsigned)(R * K + C) * 2u; voffB[i] = (unsigned)(Rb * K + C) * 2u; }
    const size_t kstep = (size_t)(BK * 2);
    const size_t hstep = (size_t)HALF * K * 2;
    const size_t tstep = 2 * hstep;
    const unsigned ldsw = (unsigned)wid * 1024u;
    const int aoff = lds_byte(wr * 64 + fr, fq * 8), boff = lds_byte(wc * 32 + fr, fq * 8);
#define PG8_SA(b, h) (((b) * 2 + (h)) * HTB)
#define PG8_SB(b, h) ((4 + (b) * 2 + (h)) * HTB)
#define PG8_STAGE(bufoff, gbase, voff) do { _Pragma("unroll") for (int _i = 0; _i < 2; ++_i) \
        __builtin_amdgcn_global_load_lds((const unsigned*)((const char*)(gbase) + (voff)[_i]), (PG8_LAS unsigned*)(lds + (bufoff) + ldsw + _i * 8192), 16, 0, 0); } while (0)
#define PG8_LDA(dst, b, h) do { _Pragma("unroll") for (int m = 0; m < 4; ++m) _Pragma("unroll") for (int k = 0; k < 2; ++k) dst[m][k] = *(const PG8_LAS bf16x8*)(lds + PG8_SA(b, h) + aoff + m * 2048 + k * 1024); } while (0)
#define PG8_LDB(dst, b, h) do { _Pragma("unroll") for (int n = 0; n < 2; ++n) _Pragma("unroll") for (int k = 0; k < 2; ++k) dst[n][k] = *(const PG8_LAS bf16x8*)(lds + PG8_SB(b, h) + boff + n * 2048 + k * 1024); } while (0)
#define PG8_MMA(ai, bj, At, Bt) do { __builtin_amdgcn_s_setprio(1); _Pragma("unroll") for (int m = 0; m < 4; ++m) _Pragma("unroll") for (int n = 0; n < 2; ++n) _Pragma("unroll") for (int k = 0; k < 2; ++k) \
        acc[ai][bj][m][n] = __builtin_amdgcn_mfma_f32_16x16x32_bf16(Bt[n][k], At[m][k], acc[ai][bj][m][n], 0, 0, 0); __builtin_amdgcn_s_setprio(0); } while (0)
#define PG8_WAIT_V(n) asm volatile("s_waitcnt vmcnt(" #n ")" ::: "memory")
#define PG8_WAIT_L(n) asm volatile("s_waitcnt lgkmcnt(" #n ")" ::: "memory")
#define PG8_BAR __builtin_amdgcn_s_barrier()
#define PG8_SCHED __builtin_amdgcn_sched_barrier(0)
    Unit cur, nxt; int ui = 0;
    if (!S.next(0, cur)) return;
    f32x4 acc[2][2][4][2];
#pragma unroll
    for (int a = 0; a < 2; ++a)
#pragma unroll
        for (int b = 0; b < 2; ++b)
#pragma unroll
            for (int m = 0; m < 4; ++m)
#pragma unroll
                for (int n = 0; n < 2; ++n) acc[a][b][m][n] = (f32x4){0.f, 0.f, 0.f, 0.f};
    bf16x8 At[4][2], B0[2][2], B1[2][2];
    const char* cA = (const char*)g.A + (size_t)S.arow(cur.pm) * (size_t)K * 2; const char* cB = (const char*)g.Bt + (size_t)cur.pn * tstep;
    S.a_ready(cur);
    if constexpr (SP2) {
        PG8_STAGE(PG8_SB(0, 0), cB, voffB); PG8_STAGE(PG8_SB(0, 1), cB + hstep, voffB); PG8_STAGE(PG8_SA(0, 0), cA, voffA); PG8_STAGE(PG8_SA(0, 1), cA + hstep, voffA);
        if (wr == 1) PG8_BAR;
        PG8_WAIT_V(2); PG8_BAR;
        PG8_STAGE(PG8_SB(1, 0), cB + kstep, voffB); PG8_STAGE(PG8_SA(1, 0), cA + kstep, voffA); PG8_STAGE(PG8_SB(1, 1), cB + hstep + kstep, voffB);
        PG8_WAIT_V(6); PG8_BAR;
    } else {
        PG8_STAGE(PG8_SB(0, 0), cB, voffB); PG8_STAGE(PG8_SA(0, 0), cA, voffA); PG8_STAGE(PG8_SB(0, 1), cB + hstep, voffB); PG8_STAGE(PG8_SA(0, 1), cA + hstep, voffA);
        if (wr == 1) PG8_BAR;
        PG8_WAIT_V(4); PG8_BAR;
        PG8_STAGE(PG8_SB(1, 0), cB + kstep, voffB); PG8_STAGE(PG8_SA(1, 0), cA + kstep, voffA); PG8_STAGE(PG8_SB(1, 1), cB + hstep + kstep, voffB);
        PG8_WAIT_V(6); PG8_BAR;
    }
    for (;;) {
        const bool has_next = S.next(ui + 1, nxt);
        const char* nA = has_next ? (const char*)g.A + (size_t)S.arow(nxt.pm) * (size_t)K * 2 : cA; const char* nB = has_next ? (const char*)g.Bt + (size_t)nxt.pn * tstep : cB;
        for (int t = 0; t < nt; t += 2) {
            const bool last = (t == nt - 2);
            const char* a1 = cA + (size_t)(t + 1) * kstep;
            const char* a2 = last ? nA : cA + (size_t)(t + 2) * kstep; const char* b2 = last ? nB : cB + (size_t)(t + 2) * kstep;
            const char* a3 = a2 + kstep; const char* b3 = b2 + kstep;
            if (last && has_next) S.a_ready(nxt);
            if constexpr (SP2) {
            PG8_LDB(B0, 0, 0); PG8_LDB(B1, 0, 1); PG8_SCHED; PG8_LDA(At, 0, 0); PG8_STAGE(PG8_SA(1, 1), a1 + hstep, voffA);
            PG8_WAIT_V(8); PG8_WAIT_L(0); PG8_BAR; PG8_MMA(0, 0, At, B0); PG8_MMA(0, 1, At, B1); PG8_BAR; PG8_SCHED;
            PG8_LDA(At, 0, 1); PG8_STAGE(PG8_SB(0, 0), b2, voffB); PG8_STAGE(PG8_SB(0, 1), b2 + hstep, voffB); PG8_STAGE(PG8_SA(0, 0), a2, voffA);
            PG8_WAIT_V(8); PG8_WAIT_L(0); PG8_BAR; PG8_MMA(1, 0, At, B0); PG8_MMA(1, 1, At, B1); PG8_BAR; PG8_SCHED;
            PG8_LDB(B0, 1, 0); PG8_LDB(B1, 1, 1); PG8_SCHED; PG8_LDA(At, 1, 0); PG8_STAGE(PG8_SA(0, 1), a2 + hstep, voffA);
            PG8_WAIT_V(8); PG8_WAIT_L(0); PG8_BAR; PG8_MMA(0, 0, At, B0); PG8_MMA(0, 1, At, B1); PG8_BAR; PG8_SCHED;
            PG8_LDA(At, 1, 1); PG8_STAGE(PG8_SB(1, 0), b3, voffB); PG8_STAGE(PG8_SB(1, 1), b3 + hstep, voffB); PG8_STAGE(PG8_SA(1, 0), a3, voffA);
            PG8_WAIT_V(8); PG8_WAIT_L(0); PG8_BAR; PG8_MMA(1, 0, At, B0); PG8_MMA(1, 1, At, B1); PG8_BAR; PG8_SCHED;
            } else {
            PG8_LDB(B0, 0, 0); PG8_SCHED; PG8_LDA(At, 0, 0); PG8_STAGE(PG8_SA(1, 1), a1 + hstep, voffA);
            PG8_WAIT_L(8); PG8_BAR; PG8_WAIT_L(0); PG8_MMA(0, 0, At, B0); PG8_BAR; PG8_SCHED;
            PG8_LDB(B1, 0, 1); PG8_STAGE(PG8_SB(0, 0), b2, voffB);
            PG8_BAR; PG8_WAIT_L(0); PG8_MMA(0, 1, At, B1); PG8_BAR;
            PG8_LDA(At, 0, 1); PG8_STAGE(PG8_SA(0, 0), a2, voffA);
            PG8_BAR; PG8_WAIT_L(0); PG8_MMA(1, 0, At, B0); PG8_BAR; PG8_SCHED;
            PG8_STAGE(PG8_SB(0, 1), b2 + hstep, voffB);
            PG8_WAIT_V(6); PG8_BAR; PG8_MMA(1, 1, At, B1); PG8_BAR;
            PG8_LDB(B0, 1, 0); PG8_SCHED; PG8_LDA(At, 1, 0); PG8_STAGE(PG8_SA(0, 1), a2 + hstep, voffA);
            PG8_WAIT_L(8); PG8_BAR; PG8_WAIT_L(0); PG8_MMA(0, 0, At, B0); PG8_BAR; PG8_SCHED;
            PG8_LDB(B1, 1, 1); PG8_STAGE(PG8_SB(1, 0), b3, voffB);
            PG8_BAR; PG8_WAIT_L(0); PG8_MMA(0, 1, At, B1); PG8_BAR;
            PG8_LDA(At, 1, 1); PG8_STAGE(PG8_SA(1, 0), a3, voffA);
            PG8_BAR; PG8_WAIT_L(0); PG8_MMA(1, 0, At, B0); PG8_BAR; PG8_SCHED;
            PG8_STAGE(PG8_SB(1, 1), b3 + hstep, voffB);
            PG8_WAIT_V(6); PG8_BAR; PG8_MMA(1, 1, At, B1); PG8_BAR;
            }
        }
        if constexpr (ALIGN_EPI) { if (wr == 0) PG8_BAR; }
        if constexpr (!Epi::AFTER_DRAIN) { E(acc, cur, wr, wc, fr, fq); S.done(cur); }
        if (!has_next) break;
#pragma unroll
        for (int a = 0; a < 2; ++a)
#pragma unroll
            for (int b = 0; b < 2; ++b)
#pragma unroll
                for (int m = 0; m < 4; ++m)
#pragma unroll
                    for (int n = 0; n < 2; ++n) acc[a][b][m][n] = (f32x4){0.f, 0.f, 0.f, 0.f};
        cur = nxt; cA = nA; cB = nB; ++ui;
        if constexpr (ALIGN_EPI) { if (wr == 1) PG8_BAR; }
    }
    PG8_WAIT_V(0);
    if constexpr (!ALIGN_EPI) { if (wr == 0) PG8_BAR; }
    PG8_BAR;
    if constexpr (Epi::AFTER_DRAIN) { E.fused(acc, cur, wr, wc, fr, fq, lds, wid, lane); S.done(cur); }
#undef PG8_SA
#undef PG8_SB
#undef PG8_STAGE
#undef PG8_LDA
#undef PG8_LDB
#undef PG8_MMA
#undef PG8_WAIT_V
#undef PG8_WAIT_L
#undef PG8_BAR
#undef PG8_SCHED
}
struct HalfOrder {
    int nM, nN, nwg, G, c;
    __host__ __device__ void init(int M, int N, int G_, int c_) { nM = M / HALF; nN = N / BM; nwg = nM * nN; G = G_; c = c_; }
    __host__ __device__ bool next(int i, Unit& u) const {
        const long L = (long)i * G + c; if (L >= nwg) return false;
        int wgid = (int)L; { const int q = nwg / NXCD, r = nwg % NXCD, xcd = wgid % NXCD, off = wgid / NXCD; wgid = (xcd < r ? xcd * (q + 1) : r * (q + 1) + (xcd - r) * q) + off; }
        const int nig = WGM * nN, gid = wgid / nig, fm = gid * WGM, gsz = (nM - fm) < WGM ? (nM - fm) : WGM;
        u.pm = fm + ((wgid % nig) % gsz); u.pn = (wgid % nig) / gsz; return true;
    }
    __device__ __forceinline__ int arow(int pm) const { return pm * HALF; }
};
struct HalfOrderMix : HalfOrder {
    __host__ __device__ bool next(int i, Unit& u) const { if (!HalfOrder::next(i, u)) return false; u.pm = (u.pm + 32 * i) % nM; return true; }
};
constexpr int PH_STG = 3 * HTB;
template <class Epi, class Sched, bool MMA_FIRST>
__device__ __forceinline__ void gemm_phase_h_impl(PG8_LAS unsigned char* lds, const Gemm g, const Sched& S, const Epi& E) {
    int tid_ = threadIdx.x; asm volatile("" : "+v"(tid_));
    const int tid = tid_, wid = __builtin_amdgcn_readfirstlane(tid >> 6), lane = tid & 63, wr = wid >> 2, wc = wid & 3, fr = lane & 15, fq = lane >> 4;
    const int K = g.K, nt = K / BK;
    unsigned voffA[2], voffB[2];
#pragma unroll
    for (int i = 0; i < 2; ++i) { int R, C; stage_rc(tid * 16 + i * 8192, R, C); const int Rb = Epi::PERM ? ((R & ~31) + perm32(R & 31)) : R;
        voffA[i] = (unsigned)(R * K + C) * 2u; voffB[i] = (unsigned)(Rb * K + C) * 2u; }
    const size_t kstep = (size_t)(BK * 2), hstep = (size_t)HALF * K * 2, tstepB = 2 * hstep;
    const unsigned ldsw = (unsigned)wid * 1024u;
    const int aoff = lds_byte(wr * 64 + fr, fq * 8), boff = lds_byte(wc * 32 + fr, fq * 8);
#define PH_STAGE(bufoff, gbase, voff) do { _Pragma("unroll") for (int _i = 0; _i < 2; ++_i) \
        __builtin_amdgcn_global_load_lds((const unsigned*)((const char*)(gbase) + (voff)[_i]), (PG8_LAS unsigned*)(lds + (bufoff) + ldsw + _i * 8192), 16, 0, 0); } while (0)
#define PH_STAGE3(so, ga, gb) do { PH_STAGE((so), ga, voffA); PH_STAGE((so) + HTB, gb, voffB); PH_STAGE((so) + 2 * HTB, (gb) + hstep, voffB); } while (0)
#define PH_LDALL(so, At, B0, B1) do { \
        _Pragma("unroll") for (int n = 0; n < 2; ++n) _Pragma("unroll") for (int k = 0; k < 2; ++k) B0[n][k] = *(const PG8_LAS bf16x8*)(lds + (so) + HTB + boff + n * 2048 + k * 1024); \
        _Pragma("unroll") for (int n = 0; n < 2; ++n) _Pragma("unroll") for (int k = 0; k < 2; ++k) B1[n][k] = *(const PG8_LAS bf16x8*)(lds + (so) + 2 * HTB + boff + n * 2048 + k * 1024); \
        _Pragma("unroll") for (int m = 0; m < 4; ++m) _Pragma("unroll") for (int k = 0; k < 2; ++k) At[m][k] = *(const PG8_LAS bf16x8*)(lds + (so) + aoff + m * 2048 + k * 1024); } while (0)
#define PH_MMA(bj, At, Bt) do { _Pragma("unroll") for (int m = 0; m < 4; ++m) _Pragma("unroll") for (int n = 0; n < 2; ++n) _Pragma("unroll") for (int k = 0; k < 2; ++k) \
        acc[0][bj][m][n] = __builtin_amdgcn_mfma_f32_16x16x32_bf16(Bt[n][k], At[m][k], acc[0][bj][m][n], 0, 0, 0); } while (0)
#define PH_SYNC6() do { __builtin_amdgcn_s_waitcnt(0x0076); asm volatile("" ::: "memory"); __builtin_amdgcn_s_barrier(); __builtin_amdgcn_sched_barrier(0); } while (0)
#define PH_SYNC0() do { __builtin_amdgcn_s_waitcnt(0x0070); asm volatile("" ::: "memory"); __builtin_amdgcn_s_barrier(); __builtin_amdgcn_sched_barrier(0); } while (0)
    Unit cur, nxt; int ui = 0;
    if (!S.next(0, cur)) return;
    f32x4 acc[1][2][4][2];
#pragma unroll
    for (int b = 0; b < 2; ++b)
#pragma unroll
        for (int m = 0; m < 4; ++m)
#pragma unroll
            for (int n = 0; n < 2; ++n) acc[0][b][m][n] = (f32x4){0.f, 0.f, 0.f, 0.f};
    bf16x8 Xa[4][2], Xb0[2][2], Xb1[2][2], Ya[4][2], Yb0[2][2], Yb1[2][2];
    const char* cA = (const char*)g.A + (size_t)S.arow(cur.pm) * (size_t)K * 2; const char* cB = (const char*)g.Bt + (size_t)cur.pn * tstepB;
    typename Epi::Pre pre; E.pre(cur, wr, wc, fr, fq, pre);
    int s0 = 0, s1 = PH_STG, s2 = 2 * PH_STG;
    PH_STAGE3(s0, cA, cB); PH_STAGE3(s1, cA + kstep, cB + kstep); PH_STAGE3(s2, cA + 2 * kstep, cB + 2 * kstep);
    PH_SYNC6();
    PH_LDALL(s0, Xa, Xb0, Xb1);
    __builtin_amdgcn_s_waitcnt(0xC07F);
    for (;;) {
        const bool has_next = S.next(ui + 1, nxt);
        const char* nA = has_next ? (const char*)g.A + (size_t)S.arow(nxt.pm) * (size_t)K * 2 : cA; const char* nB = has_next ? (const char*)g.Bt + (size_t)nxt.pn * tstepB : cB;
        for (int t = 0; t < nt; t += 2) {
            const int t3 = t + 3, t4 = t + 4;
            const char* a3 = t3 < nt ? cA + (size_t)t3 * kstep : nA + (size_t)(t3 - nt) * kstep; const char* b3 = t3 < nt ? cB + (size_t)t3 * kstep : nB + (size_t)(t3 - nt) * kstep;
            const char* a4 = t4 < nt ? cA + (size_t)t4 * kstep : nA + (size_t)(t4 - nt) * kstep; const char* b4 = t4 < nt ? cB + (size_t)t4 * kstep : nB + (size_t)(t4 - nt) * kstep;
            if constexpr (!MMA_FIRST) {
                PH_SYNC6();
                PH_STAGE3(s0, a3, b3);
                PH_LDALL(s1, Ya, Yb0, Yb1);
                __builtin_amdgcn_sched_barrier(0);
                __builtin_amdgcn_s_setprio(1); PH_MMA(0, Xa, Xb0); PH_MMA(1, Xa, Xb1); __builtin_amdgcn_s_setprio(0);
                PH_SYNC6();
                PH_STAGE3(s1, a4, b4);
                PH_LDALL(s2, Xa, Xb0, Xb1);
                __builtin_amdgcn_sched_barrier(0);
                __builtin_amdgcn_s_setprio(1); PH_MMA(0, Ya, Yb0); PH_MMA(1, Ya, Yb1); __builtin_amdgcn_s_setprio(0);
            } else {
                PH_SYNC6();
                __builtin_amdgcn_s_setprio(1); PH_MMA(0, Xa, Xb0); __builtin_amdgcn_s_setprio(0);
                __builtin_amdgcn_sched_barrier(0);
                PH_STAGE3(s0, a3, b3);
                PH_LDALL(s1, Ya, Yb0, Yb1);
                __builtin_amdgcn_sched_barrier(0);
                __builtin_amdgcn_s_setprio(1); PH_MMA(1, Xa, Xb1); __builtin_amdgcn_s_setprio(0);
                PH_SYNC6();
                __builtin_amdgcn_s_setprio(1); PH_MMA(0, Ya, Yb0); __builtin_amdgcn_s_setprio(0);
                __builtin_amdgcn_sched_barrier(0);
                PH_STAGE3(s1, a4, b4);
                PH_LDALL(s2, Xa, Xb0, Xb1);
                __builtin_amdgcn_sched_barrier(0);
                __builtin_amdgcn_s_setprio(1); PH_MMA(1, Ya, Yb1); __builtin_amdgcn_s_setprio(0);
            }
            { const int o0 = s0, o1 = s1; s0 = s2; s1 = o0; s2 = o1; }
        }
        E(acc, cur, wr, wc, fr, fq, pre);
        if (!has_next) break;
#pragma unroll
        for (int b = 0; b < 2; ++b)
#pragma unroll
            for (int m = 0; m < 4; ++m)
#pragma unroll
                for (int n = 0; n < 2; ++n) acc[0][b][m][n] = (f32x4){0.f, 0.f, 0.f, 0.f};
        cur = nxt; cA = nA; cB = nB; ++ui;
        E.pre(cur, wr, wc, fr, fq, pre);
    }
    PH_SYNC0();
#undef PH_STAGE
#undef PH_STAGE3
#undef PH_LDALL
#undef PH_MMA
#undef PH_SYNC6
#undef PH_SYNC0
}
template <class Epi, class Sched>
__device__ __forceinline__ void gemm_phase_h(PG8_LAS unsigned char* lds, const Gemm g, const Sched& S, const Epi& E) {
    if (__builtin_amdgcn_readfirstlane(threadIdx.x >> 8) == 0) gemm_phase_h_impl<Epi, Sched, false>(lds, g, S, E);
    else gemm_phase_h_impl<Epi, Sched, true>(lds, g, S, E);
}
}
#define XB_TMO      128
#define XB_XCNT(j)  (256  + 64 * (j))
#define XB_XSUB(j)  (1280 + 64 * (j))
#define XB_XGEN(j)  (2304 + 64 * (j))
#define XB_TOP      3328
#define XB_TOPGEN   3392
#define XCD_BAR_WORDS 3456
#define XB_SPIN_CAP (1u << 18)

__device__ __forceinline__ unsigned xb_ld(unsigned* p)              { return __hip_atomic_load(p, __ATOMIC_RELAXED, __HIP_MEMORY_SCOPE_AGENT); }
__device__ __forceinline__ unsigned xb_add(unsigned* p, unsigned v) { return __hip_atomic_fetch_add(p, v, __ATOMIC_RELAXED, __HIP_MEMORY_SCOPE_AGENT); }
__device__ __forceinline__ unsigned xb_xcc_id() { return (unsigned)__builtin_amdgcn_s_getreg((3 << 11) | 20) & 0xFu; }
#define XB_SPIN(cond, bar) do { unsigned _sp = 0; while (cond) { __builtin_amdgcn_s_sleep(1); \
    if ((++_sp & 255u) == 0u) { if (xb_ld(&(bar)[XB_TMO])) break; if (_sp > XB_SPIN_CAP) { atomicAdd(&(bar)[XB_TMO], 1u); break; } } } } while (0)

struct XcdBarrier {
    unsigned* bar; unsigned x;
    volatile LAS unsigned* st;
};

__device__ __forceinline__ XcdBarrier xcd_barrier_post(unsigned* bar, volatile LAS unsigned* st) {
    XcdBarrier b; b.bar = bar; b.x = xb_xcc_id(); b.st = st;
    if (threadIdx.x == 0) (void)xb_add(&bar[XB_XCNT(b.x)], 1u);
    return b;
}
__device__ __forceinline__ void xcd_barrier_complete(unsigned* bar, unsigned x, unsigned& nloc, unsigned& nx) {
    const unsigned G = gridDim.x * gridDim.y * gridDim.z;
    unsigned sum, cnt, mine, sp = 0u;
    for (;;) {
        sum = 0u; cnt = 0u; mine = 0u;
#pragma unroll
        for (unsigned j = 0; j < 16; ++j) { const unsigned c = xb_ld(&bar[XB_XCNT(j)]); sum += c; cnt += (c > 0u) ? 1u : 0u; mine = (j == x) ? c : mine; }
        if (sum == G) break;
        __builtin_amdgcn_s_sleep(1);
        if ((++sp & 255u) == 0u) { if (xb_ld(&bar[XB_TMO])) break; if (sp > XB_SPIN_CAP) { atomicAdd(&bar[XB_TMO], 1u); break; } }
    }
    nloc = mine > 0u ? mine : 1u; nx = cnt > 0u ? cnt : 1u;
}

__device__ __forceinline__ void xcd_barrier(const XcdBarrier& b) {
    asm volatile("s_waitcnt vmcnt(0)" ::: "memory");
    __syncthreads();
    if (threadIdx.x == 0) {
        unsigned* bar = b.bar;
        __builtin_amdgcn_s_waitcnt(0);
        unsigned nloc = b.st[0], nx = b.st[1];
        if (nloc == 0u) { xcd_barrier_complete(bar, b.x, nloc, nx); b.st[0] = nloc; b.st[1] = nx; }
        const unsigned old = xb_add(&bar[XB_XSUB(b.x)], 1u);
        const unsigned gen = old / nloc;
        if (old + 1u == (gen + 1u) * nloc) {
            __builtin_amdgcn_fence(__ATOMIC_RELEASE, "agent");
            asm volatile("s_waitcnt vmcnt(0)" ::: "memory");
            const unsigned og = xb_add(&bar[XB_TOP], 1u);
            const unsigned tg = og / nx;
            if (og + 1u == (tg + 1u) * nx) xb_add(&bar[XB_TOPGEN], 1u);
            else XB_SPIN(xb_ld(&bar[XB_TOPGEN]) == tg, bar);
            __builtin_amdgcn_fence(__ATOMIC_ACQUIRE, "agent");
            xb_add(&bar[XB_XGEN(b.x)], 1u);
            asm volatile("s_waitcnt vmcnt(0)" ::: "memory");
        } else {
            XB_SPIN(xb_ld(&bar[XB_XGEN(b.x)]) == gen, bar);
            __builtin_amdgcn_fence(__ATOMIC_ACQUIRE, "agent");
            asm volatile("s_waitcnt vmcnt(0)" ::: "memory");
        }
    }
    __syncthreads();
}
typedef unsigned short bf16_t;
typedef unsigned v4u __attribute__((ext_vector_type(4)));
typedef float f32x4 __attribute__((ext_vector_type(4)));
constexpr int D = 1024, NTOK = 8192, NCTX = 4096, DIN = 3072, DFF = 2816, DUP = 5632, NMOD = 6144;
constexpr float EPS = 1e-6f;
constexpr size_t MiB = 1u << 20;
constexpr size_t WS_BAR = 0, BAR_BYTES = 65536;
constexpr size_t WS_LAM = 64 * 1024, WS_ROPE = 72 * 1024, WS_KMAX = 80 * 1024, WS_MOD = 128 * 1024, WS_BIAS1 = 320 * 1024, WS_BIAS2 = 400 * 1024, WS_ROWSS = 576 * 1024;
constexpr int RS_STRIDE = 8704;
constexpr size_t WS_WIN = 1 * MiB, WS_WOUT = 13 * MiB, WS_WUP = 17 * MiB, WS_WDN = 39 * MiB;
constexpr size_t WS_XA = 50 * MiB, WS_ACT = 68 * MiB, WS_U = 112 * MiB;
constexpr size_t WS_BG = 112 * MiB, WS_P = 120 * MiB, WS_Q = 160 * MiB, WS_K = 168 * MiB, WS_V = 177 * MiB, WS_A2 = 186 * MiB;
constexpr size_t WS_XR = 202 * MiB;
constexpr size_t OUT_NK = 8388608, OUT_NV = 12582912;
constexpr int RING_BYTES = 147456, MISC_OFF = RING_BYTES, EDGE_OFF = RING_BYTES + 1024, LDS_BYTES = 159744;
constexpr int NWAVES = 8;

__device__ __forceinline__ float bf2f(bf16_t v) { return __uint_as_float(((unsigned)v) << 16); }
__device__ __forceinline__ unsigned f2bf(float f) { unsigned u = __float_as_uint(f); return (u + 0x7fffu + ((u >> 16) & 1u)) >> 16; }
__device__ __forceinline__ unsigned pk2(float lo, float hi) { return f2bf(lo) | (f2bf(hi) << 16); }
__device__ __forceinline__ int grp_of(int r) { return r < NCTX ? 0 : 1 + ((r - NCTX) >> 11); }
__device__ __forceinline__ int krow_of(int r) { return r < NCTX ? r : NCTX + ((r - NCTX) >> 11) * 2304 + 256 + ((r - NCTX) & 2047); }
__device__ __forceinline__ float silu_f(float x) { return x / (1.f + expf(-x)); }
__device__ __forceinline__ float wave_sum(float v) {
#pragma unroll
    for (int o = 1; o < 64; o <<= 1) v += __shfl_xor(v, o);
    return v;
}
__device__ __forceinline__ float wave_max(float v) {
#pragma unroll
    for (int o = 1; o < 64; o <<= 1) v = fmaxf(v, __shfl_xor(v, o));
    return v;
}
#define LDS_WAIT() asm volatile("s_waitcnt lgkmcnt(0)" ::: "memory")

struct Args { const float* in[24]; float* out; unsigned char* ws; };
struct KA {
    __device__ __forceinline__ const float* operator[](int i) const { const __attribute__((address_space(4))) unsigned char* k = (const __attribute__((address_space(4))) unsigned char*)__builtin_amdgcn_kernarg_segment_ptr(); asm volatile("" : "+s"(k)); return ((const float* const __attribute__((address_space(4)))*)k)[i]; }
};
struct AV {
    KA in;
    __device__ __forceinline__ float* out_() const { return (float*)in[24]; }
    __device__ __forceinline__ unsigned char* ws_() const { return (unsigned char*)in[25]; }
};

__device__ __forceinline__ void p0_transpose_load(f32x4 (&wv)[8], const float* W, int N, int item, int lane) {
    const int nblk = N / 32, kb = item / nblk, nb = item % nblk, k0 = 64 * kb, n0 = 32 * nb;
#pragma unroll
    for (int i = 0; i < 8; ++i) wv[i] = __builtin_nontemporal_load((const f32x4*)&W[(size_t)(k0 + i * 8 + (lane >> 3)) * N + n0 + (lane & 7) * 4]);
}
template <int MAP> __device__ __forceinline__ void p0_transpose_item(const f32x4 (&wv)[8], int K, int N, bf16_t* WT, LAS float* scr, int item, int lane) {
    const int nblk = N / 32, kb = item / nblk, nb = item % nblk, k0 = 64 * kb, n0 = 32 * nb;
#pragma unroll
    for (int i = 0; i < 8; ++i) { LAS float* d = scr + (i * 8 + (lane >> 3)) * 33 + (lane & 7) * 4; d[0] = wv[i][0]; d[1] = wv[i][1]; d[2] = wv[i][2]; d[3] = wv[i][3]; }
    LDS_WAIT(); asm volatile("" ::: "memory");
    const int c = lane & 7;
#pragma unroll
    for (int j = 0; j < 4; ++j) { const int n = (lane >> 3) + 8 * j; const LAS float* s = scr + (8 * c) * 33 + n;
        v4u o; o.x = pk2(s[0 * 33], s[1 * 33]); o.y = pk2(s[2 * 33], s[3 * 33]); o.z = pk2(s[4 * 33], s[5 * 33]); o.w = pk2(s[6 * 33], s[7 * 33]);
        int prow = n0 + n; if (MAP == 1) { const int bj = prow / DFF, j = prow - bj * DFF; prow = (j >> 7) * 256 + bj * 128 + (j & 127); }
        if (MAP == 2) { if (prow < 1024) { const int w = prow & 255, d = w & 63; prow = (prow & ~255) + (d >> 5) * 128 + (w >> 6) * 32 + (d & 31); }
                        else if (prow >= 2048) { const int x = prow >= 2560, j = prow - (x ? 2560 : 2048); prow = (8 + (j >> 7)) * 256 + x * 128 + (j & 127); } }
        *(v4u*)(WT + (size_t)prow * K + k0 + 8 * c) = o; }
    LDS_WAIT(); asm volatile("" ::: "memory");
}

__device__ __forceinline__ void kmax_update(unsigned* p, float v) { atomicMax(p, __float_as_uint(v)); }
namespace pg8 {
template <int AI> struct EpiInProj {
    static constexpr bool PERM = false, AFTER_DRAIN = false;
    struct Pre {}; __device__ __forceinline__ void pre(const Unit&, int, int, int, int, Pre&) const {}
    int l; const float* qg; const float* kg; const float* rope; bf16_t* Q; bf16_t* K; bf16_t* V; bf16_t* BG; bf16_t* P; float* out; unsigned* kmax; const float* rowss; const float* bias;
    __device__ __forceinline__ void operator()(f32x4 (&acc)[AI][2][4][2], const Unit& u, int wr, int wc, int fr_, int fq_, const Pre&) const {
        int fr = fr_, fq = fq_; asm volatile("" : "+v"(fr), "+v"(fq));
        const int r0 = u.pm * (AI * HALF), pn = u.pn; const bool ctx = r0 < 4096;
        const int seqb = ctx ? 0 : (r0 - 4096) >> 11;
        { f32x4 bv[2][2];
#pragma unroll
          for (int bj = 0; bj < 2; ++bj)
#pragma unroll
              for (int n = 0; n < 2; ++n) bv[bj][n] = *(const f32x4*)(bias + (size_t)(ctx ? 0 : 1 + seqb) * 3072 + pn * BM + bj * HALF + wc * 32 + n * 16 + 4 * fq);
#pragma unroll
          for (int ai = 0; ai < AI; ++ai)
#pragma unroll
              for (int m = 0; m < 4; ++m) { const float rs = rsqrtf(rowss[r0 + ai * HALF + wr * 64 + m * 16 + fr] * (1.f / 1024.f) + EPS);
#pragma unroll
                  for (int bj = 0; bj < 2; ++bj)
#pragma unroll
                      for (int n = 0; n < 2; ++n) acc[ai][bj][m][n] = acc[ai][bj][m][n] * rs + bv[bj][n]; } }
        if (pn < 4) {
            const bool isk = pn >= 2; const float* gw = isk ? kg : qg;
            f32x4 g[2][2];
#pragma unroll
            for (int bj = 0; bj < 2; ++bj)
#pragma unroll
                for (int n = 0; n < 2; ++n) g[bj][n] = *(const f32x4*)(gw + 32 * bj + 16 * n + 4 * fq);
            const int cb = 256 * (pn & 1) + 64 * wc + 4 * fq;
            float kmx = 0.f;
#pragma unroll
            for (int ai = 0; ai < AI; ++ai)
#pragma unroll
                for (int m = 0; m < 4; ++m) { const int row = r0 + ai * HALF + wr * 64 + m * 16 + fr;
                    float ss = 0.f;
#pragma unroll
                    for (int bj = 0; bj < 2; ++bj)
#pragma unroll
                        for (int n = 0; n < 2; ++n) { const f32x4 z = acc[ai][bj][m][n]; ss += (z[0] * z[0] + z[1] * z[1]) + (z[2] * z[2] + z[3] * z[3]); }
                    ss += __shfl_xor(ss, 16); ss += __shfl_xor(ss, 32);
                    const float rs = rsqrtf(ss * (1.f / 64.f) + EPS);
                    f32x4 v[2][2]; float kss = 0.f;
#pragma unroll
                    for (int bj = 0; bj < 2; ++bj)
#pragma unroll
                        for (int n = 0; n < 2; ++n) { v[bj][n] = acc[ai][bj][m][n] * rs * g[bj][n]; const f32x4 q = v[bj][n]; kss += (q[0] * q[0] + q[1] * q[1]) + (q[2] * q[2] + q[3] * q[3]); }
                    if (isk) { kss += __shfl_xor(kss, 16); kss += __shfl_xor(kss, 32); kmx = fmaxf(kmx, kss);
                        if (ctx) { float* nk = out + OUT_NK + ((size_t)((row >> 8) * 2 + l) * 256 + (row & 255)) * 512 + cb;
#pragma unroll
                            for (int bj = 0; bj < 2; ++bj)
#pragma unroll
                                for (int n = 0; n < 2; ++n) __builtin_nontemporal_store(v[bj][n], (f32x4*)(nk + 32 * bj + 16 * n)); } }
                    if (!ctx) { const int t = (row - 4096) & 2047;
#pragma unroll
                        for (int bj = 0; bj < 2; ++bj) { const int pos = bj ? (t & 63) : (t >> 6);
                            const f32x4 cs0 = *(const f32x4*)(rope + (pos * 16 + 4 * fq) * 2), cs1 = *(const f32x4*)(rope + (pos * 16 + 4 * fq) * 2 + 4);
                            const float c[4] = {cs0[0], cs0[2], cs1[0], cs1[2]}, s[4] = {cs0[1], cs0[3], cs1[1], cs1[3]};
                            const f32x4 x1 = v[bj][0], x2 = v[bj][1];
#pragma unroll
                            for (int e = 0; e < 4; ++e) { v[bj][0][e] = x1[e] * c[e] - x2[e] * s[e]; v[bj][1][e] = x2[e] * c[e] + x1[e] * s[e]; } } }
                    const int krow = ctx ? row : 4096 + seqb * 2304 + 256 + ((row - 4096) & 2047);
                    bf16_t* dst = (isk ? K + (size_t)krow * 512 : Q + (size_t)row * 512) + cb;
#pragma unroll
                    for (int bj = 0; bj < 2; ++bj) { const u32x4 w = pair16(v[bj][0], v[bj][1]); *(u32x4*)(dst - 4 * fq + 32 * bj + pair16_col(fq)) = w; }
                }
            if (isk) {
                kmx = fmaxf(kmx, __shfl_xor(kmx, 1)); kmx = fmaxf(kmx, __shfl_xor(kmx, 2)); kmx = fmaxf(kmx, __shfl_xor(kmx, 4)); kmx = fmaxf(kmx, __shfl_xor(kmx, 8));
                if (fr == 0 && fq == 0) kmax_update(kmax + l * 256 + (ctx ? (r0 >> 8) : 16 + seqb) * 8 + 4 * (pn & 1) + wc, kmx);
            }
        } else if (pn < 8) {
            const bool isv = pn < 6; const int cb = 256 * (pn & 1) + wc * 32 + 4 * fq;
#pragma unroll
            for (int ai = 0; ai < AI; ++ai)
#pragma unroll
                for (int m = 0; m < 4; ++m) { const int row = r0 + ai * HALF + wr * 64 + m * 16 + fr;
                    const int krow = ctx ? row : 4096 + seqb * 2304 + 256 + ((row - 4096) & 2047);
                    bf16_t* dst = (isv ? V + (size_t)krow * 512 : BG + (size_t)row * 512) + cb;
                    float* nv = out + OUT_NV + ((size_t)((row >> 8) * 2 + l) * 256 + (row & 255)) * 512 + cb;
#pragma unroll
                    for (int bj = 0; bj < 2; ++bj) { const u32x4 w = pair16(acc[ai][bj][m][0], acc[ai][bj][m][1]); *(u32x4*)(dst - 4 * fq + 128 * bj + pair16_col(fq)) = w;
#pragma unroll
                        for (int n = 0; n < 2; ++n) if (isv && ctx) __builtin_nontemporal_store(acc[ai][bj][m][n], (f32x4*)(nv + 128 * bj + 16 * n)); } }
        } else {
            const int cb = 128 * (pn - 8) + wc * 32 + 4 * fq;
#pragma unroll
            for (int ai = 0; ai < AI; ++ai)
#pragma unroll
                for (int m = 0; m < 4; ++m) { const int row = r0 + ai * HALF + wr * 64 + m * 16 + fr;
                    { const u32x4 w = pair16(acc[ai][0][m][0] * acc[ai][1][m][0], acc[ai][0][m][1] * acc[ai][1][m][1]); *(u32x4*)(P + (size_t)row * 512 + cb - 4 * fq + pair16_col(fq)) = w; } }
        }
    }
};
}
template <int MAP> __device__ __forceinline__ void p0_transpose_mini(const float* W, int K, int N, bf16_t* WT, LAS float* scr, int item, int lane, int w) {
    const int nblk = N / 32, kb = item / nblk, nb = item % nblk, k0 = 64 * kb, n0 = 32 * nb;
    const f32x4 v = __builtin_nontemporal_load((const f32x4*)&W[(size_t)(k0 + 8 * w + (lane >> 3)) * N + n0 + (lane & 7) * 4]);
    { LAS float* d = scr + (8 * w + (lane >> 3)) * 33 + (lane & 7) * 4; d[0] = v[0]; d[1] = v[1]; d[2] = v[2]; d[3] = v[3]; }
    LDS_WAIT(); asm volatile("" ::: "memory");
    { const int n = lane & 31; const LAS float* s = scr + (8 * w) * 33 + n;
      if (lane < 32) {
        v4u o; o.x = pk2(s[0 * 33], s[1 * 33]); o.y = pk2(s[2 * 33], s[3 * 33]); o.z = pk2(s[4 * 33], s[5 * 33]); o.w = pk2(s[6 * 33], s[7 * 33]);
        int prow = n0 + n; if (MAP == 1) { const int bj = prow / DFF, j = prow - bj * DFF; prow = (j >> 7) * 256 + bj * 128 + (j & 127); }
        if (MAP == 2) { if (prow < 1024) { const int ww = prow & 255, d = ww & 63; prow = (prow & ~255) + (d >> 5) * 128 + (ww >> 6) * 32 + (d & 31); }
                        else if (prow >= 2048) { const int x = prow >= 2560, j = prow - (x ? 2560 : 2048); prow = (8 + (j >> 7)) * 256 + x * 128 + (j & 127); } }
        *(v4u*)(WT + (size_t)prow * K + k0 + 8 * w) = o; } }
    LDS_WAIT(); asm volatile("" ::: "memory");
}
__device__ __forceinline__ void phase_prologue(const AV a, LAS unsigned char* lds, int tid, int lane, int wave, int vcu, int G) {
    unsigned char* ws = a.ws_();
    const int bx = blockIdx.x;
    const int gw = vcu * NWAVES + wave, NGW = G * NWAVES;
    constexpr int I_IN = (D / 64) * (DIN / 32), I_OUT = (D / 64) * (D / 32), I_UP = (D / 64) * (DUP / 32), I_DN = (DFF / 64) * (D / 32), I_L = I_IN + I_OUT + I_UP + I_DN;
    const int FULL = (2 * I_L / NGW) * NGW;
    auto fetch = [&](f32x4 (&wv)[8], int it) {
        const int l = it / I_L; int r = it % I_L;
        if (r < I_IN) { p0_transpose_load(wv, a.in[9] + (size_t)l * D * DIN, DIN, r, lane); return; } r -= I_IN;
        if (r < I_OUT) { p0_transpose_load(wv, a.in[19] + (size_t)l * D * D, D, r, lane); return; } r -= I_OUT;
        if (r < I_UP) { p0_transpose_load(wv, a.in[21] + (size_t)l * D * DUP, DUP, r, lane); return; } r -= I_UP;
        p0_transpose_load(wv, a.in[23] + (size_t)l * DFF * D, D, r, lane);
    };
    f32x4 nx[8];
    if (gw < FULL) fetch(nx, gw);
    for (int it = bx; it < 256; it += G) {
        LAS float* sc = (LAS float*)lds;
        LAS float* red = (LAS float*)(lds + 12288);
        __syncthreads();
        for (int i = tid; i < 1024; i += 512) { sc[i] = silu_f(a.in[5][i]); sc[1024 + i] = silu_f(a.in[4][i]); sc[2048 + i] = silu_f(a.in[4][1024 + i]); }
        __syncthreads();
        const int l = it >> 7, n0 = (it & 127) * 48, ln = lane < 48 ? lane : 47;
        const float* wp = a.in[6] + (size_t)l * D * NMOD + (size_t)(wave * 128) * NMOD + n0 + ln;
        float a0 = 0.f, a1 = 0.f, a2 = 0.f;
#pragma unroll
        for (int k = 0; k < 128; ++k) { const float wv = __builtin_nontemporal_load(&wp[(size_t)k * NMOD]); const int kk = wave * 128 + k; a0 += sc[kk] * wv; a1 += sc[1024 + kk] * wv; a2 += sc[2048 + kk] * wv; }
        red[(wave * 3 + 0) * 64 + lane] = a0; red[(wave * 3 + 1) * 64 + lane] = a1; red[(wave * 3 + 2) * 64 + lane] = a2;
        __syncthreads();
        if (wave < 3 && lane < 48) {
            float s = 0.f;
#pragma unroll
            for (int w = 0; w < 8; ++w) s += red[(w * 3 + wave) * 64 + lane];
            ((float*)(ws + WS_MOD))[((size_t)l * 3 + wave) * NMOD + n0 + lane] = s + a.in[7][l * NMOD + n0 + lane];
        }
        __syncthreads();
    }
    if (bx == G - 1) {
        if (tid < 2) {
            const int l = tid; float s1 = 0.f, s2 = 0.f;
            for (int i = 0; i < 64; ++i) { s1 += a.in[12][l * 64 + i] * a.in[13][l * 64 + i]; s2 += a.in[14][l * 64 + i] * a.in[15][l * 64 + i]; }
            const float lam_init = 0.8f - 0.6f * expf(-0.3f * (float)l);
            float* lam = (float*)(ws + WS_LAM);
            lam[l * 2 + 0] = expf(s1) - expf(s2) + lam_init; lam[l * 2 + 1] = lam_init;
        }
        for (int i = tid; i < 512; i += 512) ((unsigned*)(ws + WS_KMAX))[i] = 0u;
    }
    { float* rope = (float*)(ws + WS_ROPE);
      const int per = (64 * 16 + G - 1) / G, i = bx * per + tid;
      if (tid < per && i < 64 * 16) {
          const int pos = i >> 4, f = i & 15;
          const float ang = (float)pos * powf(10000.f, -(float)f / 16.f);
          rope[i * 2 + 0] = cosf(ang); rope[i * 2 + 1] = sinf(ang);
      }
    }
    for (int i = bx * 512 + tid; i < 4 * RS_STRIDE; i += G * 512) ((float*)(ws + WS_ROWSS))[i] = 0.f;
    LAS float* scr = (LAS float*)(lds + wave * 16384);
    for (int it = gw; it < FULL; it += NGW) {
        f32x4 cu[8];
#pragma unroll
        for (int i = 0; i < 8; ++i) cu[i] = nx[i];
        if (it + NGW < FULL) fetch(nx, it + NGW);
        const int l = it / I_L; int r = it % I_L;
        if (r < I_IN) { p0_transpose_item<2>(cu, D, DIN, (bf16_t*)(ws + WS_WIN) + (size_t)l * DIN * D, scr, r, lane); continue; } r -= I_IN;
        if (r < I_OUT) { p0_transpose_item<0>(cu, D, D, (bf16_t*)(ws + WS_WOUT) + (size_t)l * D * D, scr, r, lane); continue; } r -= I_OUT;
        if (r < I_UP) { p0_transpose_item<1>(cu, D, DUP, (bf16_t*)(ws + WS_WUP) + (size_t)l * DUP * D, scr, r, lane); continue; } r -= I_UP;
        p0_transpose_item<0>(cu, DFF, D, (bf16_t*)(ws + WS_WDN) + (size_t)l * D * DFF, scr, r, lane);
    }
    for (int it = FULL + vcu; it < 2 * I_L; it += G) {
        const int l = it / I_L; int r = it % I_L;
        if (r < I_IN) { p0_transpose_mini<2>(a.in[9] + (size_t)l * D * DIN, D, DIN, (bf16_t*)(ws + WS_WIN) + (size_t)l * DIN * D, scr, r, lane, wave); continue; } r -= I_IN;
        if (r < I_OUT) { p0_transpose_mini<0>(a.in[19] + (size_t)l * D * D, D, D, (bf16_t*)(ws + WS_WOUT) + (size_t)l * D * D, scr, r, lane, wave); continue; } r -= I_OUT;
        if (r < I_UP) { p0_transpose_mini<1>(a.in[21] + (size_t)l * D * DUP, D, DUP, (bf16_t*)(ws + WS_WUP) + (size_t)l * DUP * D, scr, r, lane, wave); continue; } r -= I_UP;
        p0_transpose_mini<0>(a.in[23] + (size_t)l * DFF * D, DFF, D, (bf16_t*)(ws + WS_WDN) + (size_t)l * D * DFF, scr, r, lane, wave);
    }
}

__device__ __forceinline__ void phase_prep(const AV a, int lane, int gw, int NGW) {
    unsigned char* ws = a.ws_();
    constexpr int CH = 9, NCI = (DIN + CH - 1) / CH, NCU = (DUP + CH - 1) / CH, NCL = NCI + NCU;
    for (int c = gw; c < 2 * NCL; c += NGW) {
        const int l = c / NCL; int cc = c - l * NCL;
        const bool up = cc >= NCI; if (up) cc -= NCI;
        const int nrows = up ? DUP : DIN, q0 = cc * CH;
        const bf16_t* wt = (up ? (const bf16_t*)(ws + WS_WUP) + (size_t)l * DUP * D : (const bf16_t*)(ws + WS_WIN) + (size_t)l * DIN * D) + lane * 16;
        const float* sh = (const float*)(ws + WS_MOD) + (size_t)l * 3 * NMOD + (up ? 3 * D : 0) + lane * 16;
        v4u w[CH][2];
#pragma unroll
        for (int i = 0; i < CH; ++i) { const int q = q0 + i < nrows ? q0 + i : nrows - 1; w[i][0] = *(const v4u*)(wt + (size_t)q * D); w[i][1] = *(const v4u*)(wt + (size_t)q * D + 8); }
        f32x4 t[3][4];
#pragma unroll
        for (int g = 0; g < 3; ++g)
#pragma unroll
            for (int j = 0; j < 4; ++j) t[g][j] = *(const f32x4*)(sh + (size_t)g * NMOD + 4 * j);
        float* dst = (up ? (float*)(ws + WS_BIAS2) + (size_t)l * 3 * DUP : (float*)(ws + WS_BIAS1) + (size_t)l * 3 * DIN) + (size_t)(lane < 3 ? lane : 0) * nrows;
#pragma unroll
        for (int i = 0; i < CH; ++i) {
            float wv[16];
#pragma unroll
            for (int j = 0; j < 4; ++j) { wv[2 * j] = __uint_as_float(w[i][0][j] << 16); wv[2 * j + 1] = __uint_as_float(w[i][0][j] & 0xffff0000u); wv[8 + 2 * j] = __uint_as_float(w[i][1][j] << 16); wv[8 + 2 * j + 1] = __uint_as_float(w[i][1][j] & 0xffff0000u); }
            float s3[3];
#pragma unroll
            for (int g = 0; g < 3; ++g) { float acc = 0.f;
#pragma unroll
                for (int j = 0; j < 4; ++j) acc += t[g][j][0] * wv[4 * j] + t[g][j][1] * wv[4 * j + 1] + t[g][j][2] * wv[4 * j + 2] + t[g][j][3] * wv[4 * j + 3];
                s3[g] = wave_sum(acc); }
            if (lane < 3 && q0 + i < nrows) dst[q0 + i] = lane == 0 ? s3[0] : (lane == 1 ? s3[1] : s3[2]);
        }
    }
    const float* g1 = a.in[8];
    f32x4 gn[4];
#pragma unroll
    for (int j = 0; j < 4; ++j) gn[j] = *(const f32x4*)(g1 + 4 * lane + 256 * j);
    for (int rb = gw; rb < NTOK; rb += 4 * NGW) {
        f32x4 v[4][4], mul[4][4];
#pragma unroll
        for (int i = 0; i < 4; ++i) { const int r = rb + i * NGW < NTOK ? rb + i * NGW : rb;
            const float* x = r < NCTX ? a.in[0] + (size_t)r * D : a.in[1] + (size_t)(r - NCTX) * D;
            const float* sc = (const float*)(ws + WS_MOD) + (size_t)grp_of(r) * NMOD + D;
#pragma unroll
            for (int j = 0; j < 4; ++j) { v[i][j] = __builtin_nontemporal_load((const f32x4*)(x + 4 * lane + 256 * j)); mul[i][j] = *(const f32x4*)(sc + 4 * lane + 256 * j); } }
#pragma unroll
        for (int i = 0; i < 4; ++i)
#pragma unroll
            for (int j = 0; j < 4; ++j) { asm volatile("" : "+v"(v[i][j]), "+v"(mul[i][j])); }
#pragma unroll
        for (int i = 0; i < 4; ++i) { const int r = rb + i * NGW;
            if (r < NTOK) {
                float ss = 0.f;
#pragma unroll
                for (int j = 0; j < 4; ++j) ss += (v[i][j].x * v[i][j].x + v[i][j].y * v[i][j].y) + (v[i][j].z * v[i][j].z + v[i][j].w * v[i][j].w);
                ss = wave_sum(ss);
                if (lane == 0) ((float*)(ws + WS_ROWSS))[r] = ss;
                bf16_t* o = (bf16_t*)(ws + WS_XA) + (size_t)r * D;
#pragma unroll
                for (int j = 0; j < 4; ++j) { const int c = 4 * lane + 256 * j;
                    const f32x4 y = v[i][j] * gn[j] * (mul[i][j] + 1.f);
                    uint2 w2; w2.x = pk2(y.x, y.y); w2.y = pk2(y.z, y.w); *(uint2*)(o + c) = w2; } } }
    }
}

__device__ __forceinline__ void step_cache_rows(const AV a, int l, int lane, int gw, int NGW) {
    unsigned char* ws = a.ws_();
    for (int i = gw; i < 512; i += NGW) {
        const int b = i >> 8, pos = i & 255;
        const float* ck = a.in[2] + ((size_t)(b * 2 + l) * 256 + pos) * 512 + lane * 8;
        const float* cv = a.in[3] + ((size_t)(b * 2 + l) * 256 + pos) * 512 + lane * 8;
        const f32x4 k0 = __builtin_nontemporal_load((const f32x4*)ck), k1 = __builtin_nontemporal_load((const f32x4*)(ck + 4)), v0 = __builtin_nontemporal_load((const f32x4*)cv), v1 = __builtin_nontemporal_load((const f32x4*)(cv + 4));
        v4u kw, vw; kw.x = pk2(k0.x, k0.y); kw.y = pk2(k0.z, k0.w); kw.z = pk2(k1.x, k1.y); kw.w = pk2(k1.z, k1.w);
        vw.x = pk2(v0.x, v0.y); vw.y = pk2(v0.z, v0.w); vw.z = pk2(v1.x, v1.y); vw.w = pk2(v1.z, v1.w);
        float kss = (k0.x * k0.x + k0.y * k0.y) + (k0.z * k0.z + k0.w * k0.w) + (k1.x * k1.x + k1.y * k1.y) + (k1.z * k1.z + k1.w * k1.w);
        kss += __shfl_xor(kss, 1); kss += __shfl_xor(kss, 2); kss += __shfl_xor(kss, 4);
        if ((lane & 7) == 0) kmax_update((unsigned*)(ws + WS_KMAX) + l * 256 + (16 + b) * 8 + (lane >> 3), kss);
        *(v4u*)((bf16_t*)(ws + WS_K) + (size_t)(NCTX + b * 2304 + pos) * 512 + lane * 8) = kw;
        *(v4u*)((bf16_t*)(ws + WS_V) + (size_t)(NCTX + b * 2304 + pos) * 512 + lane * 8) = vw;
    }
}
__device__ __forceinline__ void convbr_rows(const AV a, int l, int rbase, int lane, int wave) {
    unsigned char* ws = a.ws_();
    const float* cw = a.in[17] + l * 3 * 512 + lane * 8;
    const float* gn = a.in[18] + l * 512 + lane * 8;
    v4u pc[2], pu[2], pd[2], bg[2];
    const v4u z4 = {0u, 0u, 0u, 0u};
#pragma unroll
    for (int k = 0; k < 2; ++k) { const int r = rbase + 2 * wave + k;
        const bool lat = r >= NCTX; const int t = lat ? ((r - NCTX) & 2047) : (r & 255), len = lat ? 2048 : 256;
        const bf16_t* P = (const bf16_t*)(ws + WS_P) + (size_t)r * 512 + lane * 8;
        pc[k] = *(const v4u*)P; pu[k] = (t > 0) ? *(const v4u*)(P - 512) : z4; pd[k] = (t < len - 1) ? *(const v4u*)(P + 512) : z4;
        bg[k] = *(const v4u*)((const bf16_t*)(ws + WS_BG) + (size_t)r * 512 + lane * 8); }
    float w0[8], w1[8], w2[8], g[8];
#pragma unroll
    for (int j = 0; j < 8; ++j) { w0[j] = cw[j]; w1[j] = cw[512 + j]; w2[j] = cw[1024 + j]; g[j] = gn[j]; }
#pragma unroll
    for (int k = 0; k < 2; ++k) { const int r = rbase + 2 * wave + k;
        float y[8]; float ss = 0.f;
#pragma unroll
        for (int j = 0; j < 8; ++j) {
            const float c = __uint_as_float((j & 1) ? (pc[k][j >> 1] & 0xffff0000u) : (pc[k][j >> 1] << 16)), u = __uint_as_float((j & 1) ? (pu[k][j >> 1] & 0xffff0000u) : (pu[k][j >> 1] << 16));
            const float d = __uint_as_float((j & 1) ? (pd[k][j >> 1] & 0xffff0000u) : (pd[k][j >> 1] << 16)), b = __uint_as_float((j & 1) ? (bg[k][j >> 1] & 0xffff0000u) : (bg[k][j >> 1] << 16));
            y[j] = b * (w0[j] * u + w1[j] * c + w2[j] * d); ss += y[j] * y[j]; }
        ss = wave_sum(ss);
        const float rs = rsqrtf(ss * (1.f / 512.f) + EPS);
        v4u o; o.x = pk2(y[0] * rs * g[0], y[1] * rs * g[1]); o.y = pk2(y[2] * rs * g[2], y[3] * rs * g[3]); o.z = pk2(y[4] * rs * g[4], y[5] * rs * g[5]); o.w = pk2(y[6] * rs * g[6], y[7] * rs * g[7]);
        *(v4u*)((bf16_t*)(ws + WS_A2) + (size_t)r * D + 512 + lane * 8) = o; }
}

namespace att {
using bf16x8 = __attribute__((ext_vector_type(8))) short;
using s16x4  = __attribute__((ext_vector_type(4))) short;
using f32x16 = __attribute__((ext_vector_type(16))) float;
using u32x4  = __attribute__((ext_vector_type(4))) unsigned;
#define KSWZ(row, colB) ((row) * 256 + ((colB) ^ (((row) & 7) << 4)))
#define SBAR() __builtin_amdgcn_sched_barrier(0)
__device__ __forceinline__ int crow(int r, int hi) { return (r & 3) + 8 * (r >> 2) + 4 * hi; }
__device__ __forceinline__ unsigned cvtpk(float lo, float hi) { unsigned r; asm volatile("v_cvt_pk_bf16_f32 %0, %1, %2" : "=v"(r) : "v"(lo), "v"(hi)); return r; }
__device__ __forceinline__ int v_st(int k, int c) { const int kk = (k & ~0xC) | ((k & 4) << 1) | ((k & 8) >> 1); return ((kk >> 3) * 4 + (c >> 5)) * 512 + ((kk & 7) * 32 + (c & 31)) * 2; }
__device__ __forceinline__ int v_rd_base(int lane) { return ((lane & 3) << 3) | (((lane >> 2) & 3) << 6) | (((lane >> 4) & 1) << 5) | (((lane >> 5) & 1) << 8); }
constexpr int v_rd_off(int d0, int ks, int half) { return d0 * 512 + ks * 4096 + half * 2048; }
template <int OFF> __device__ __forceinline__ s16x4 tr_read(int vb) {
    s16x4 r; asm volatile("ds_read_b64_tr_b16 %0, %1 offset:%2" : "=&v"(r) : "v"(vb), "i"(OFF) : "memory"); return r;
}
template <int D0> __device__ __forceinline__ void pv_one(f32x16& od, int vb, bf16x8 pa0, bf16x8 pa1, bf16x8 pa2, bf16x8 pa3) {
    const s16x4 l0 = tr_read<v_rd_off(D0, 0, 0)>(vb), h0 = tr_read<v_rd_off(D0, 0, 1)>(vb), l1 = tr_read<v_rd_off(D0, 1, 0)>(vb), h1 = tr_read<v_rd_off(D0, 1, 1)>(vb);
    const s16x4 l2 = tr_read<v_rd_off(D0, 2, 0)>(vb), h2 = tr_read<v_rd_off(D0, 2, 1)>(vb), l3 = tr_read<v_rd_off(D0, 3, 0)>(vb), h3 = tr_read<v_rd_off(D0, 3, 1)>(vb);
    asm volatile("s_waitcnt lgkmcnt(0)" ::: "memory"); SBAR();
#define PK(L, H) (bf16x8){L[0], L[1], L[2], L[3], H[0], H[1], H[2], H[3]}
    od = __builtin_amdgcn_mfma_f32_32x32x16_bf16(pa0, PK(l0, h0), od, 0, 0, 0);
    od = __builtin_amdgcn_mfma_f32_32x32x16_bf16(pa1, PK(l1, h1), od, 0, 0, 0);
    od = __builtin_amdgcn_mfma_f32_32x32x16_bf16(pa2, PK(l2, h2), od, 0, 0, 0);
    od = __builtin_amdgcn_mfma_f32_32x32x16_bf16(pa3, PK(l3, h3), od, 0, 0, 0);
#undef PK
}
constexpr int LDS_STAGE = 65536, LDS_V = 0, LDS_K = 32768, LDS_P1 = 0, LDS_OT = 65536, LDS_WS = 98304;
constexpr float SC_C = 0.125f * 1.4426950408889634f;

__device__ __forceinline__ void attn_unit(const bf16_t* __restrict__ Qb, const bf16_t* __restrict__ Kh, const bf16_t* __restrict__ Vh, int nk, float kmax2_0, float kmax2_1,
                                          float lam, float lam_init, const float* __restrict__ subg, bf16_t* __restrict__ A2o, LAS unsigned char* lds, const AV a, int layer, int conv_rbase) {
    int tid_ = threadIdx.x; asm volatile("" : "+v"(tid_));
    const int tid = tid_, wave = __builtin_amdgcn_readfirstlane(tid >> 6), lane = tid & 63, r32 = lane & 31, hi = lane >> 5;
    const int qg = wave & 1, s = (wave >> 1) & 1, kh = wave >> 2;
    LAS float* li_l = (LAS float*)(lds + LDS_WS + wave * 256);
    LAS float* lpart = (LAS float*)(lds + LDS_WS + 2048);
    LAS float* OT = (LAS float*)(lds + LDS_OT);
    LAS float* P1 = (LAS float*)(lds + LDS_P1);
    bf16x8 qr[4];
    const bf16_t* Qw = Qb + (size_t)(qg * 32 + r32) * 512 + s * 64 + hi * 8;
    float qss = 0.f;
#pragma unroll
    for (int d0 = 0; d0 < 4; ++d0) { qr[d0] = *(const bf16x8*)(Qw + d0 * 16);
#pragma unroll
        for (int j = 0; j < 8; ++j) { const float q = __uint_as_float(((unsigned)(unsigned short)qr[d0][j]) << 16); qss += q * q; } }
    qss += __shfl_xor(qss, 32);
    const float mC = -(sqrtf(qss * (s ? kmax2_1 : kmax2_0)) * 1.01f) * SC_C;
    const int vb0 = (int)(unsigned)(size_t)(lds + LDS_V) + v_rd_base(lane) + kh * 16384;
    unsigned soff[8];
#pragma unroll
    for (int i = 0; i < 8; ++i) { const int q = (wave & 1) * 8 + i;
        if (wave < 4) { const int sub = 2 * q + (lane >> 5), kk = (sub >> 2) * 8 + ((lane & 31) >> 2), c = (sub & 3) * 32 + (lane & 3) * 8;
                        const int k = (kk & ~0xC) | ((kk & 4) << 1) | ((kk & 8) >> 1); soff[i] = (unsigned)(k * 1024 + c * 2); }
        else          { const int row = q * 4 + (lane >> 4), ch = (lane & 15) ^ (row & 15); soff[i] = (unsigned)(row * 1024 + ch * 16); } }
    const char* gsrc = (const char*)(wave < 4 ? Vh : Kh) + (size_t)(((wave >> 1) & 1) * 64) * 1024;
    const int ldst = (wave >> 1) * 16384 + (wave & 1) * 8192;
#define STAGE(b, key0) do { const char* g_ = gsrc + (size_t)(key0) * 1024; _Pragma("unroll") for (int i = 0; i < 8; ++i) \
        __builtin_amdgcn_global_load_lds((const unsigned*)(g_ + soff[i]), (LAS unsigned*)(lds + (b) * LDS_STAGE + ldst + i * 1024), 16, 0, 0); } while (0)
#define LBARV() do { asm volatile("s_waitcnt vmcnt(0) lgkmcnt(0)" ::: "memory"); __builtin_amdgcn_s_barrier(); asm volatile("" ::: "memory"); } while (0)
    f32x16 o0 = {}, o1 = {}, o2 = {}, o3 = {}; float l = 0.f;
    const int NS = nk >> 7;
    STAGE(0, 0);
    convbr_rows(a, layer, conv_rbase, lane, wave);
    LBARV();
    const int ldsb = (int)(unsigned)(size_t)lds;
    int kad0, kad1, kad2, kad3;
    { const int sw = (r32 & 15) << 4, rb = ldsb + LDS_K + kh * 16384 + r32 * 256, cs = s * 128 + hi * 16;
      kad0 = rb + ((cs + 0 * 32) ^ sw); kad1 = rb + ((cs + 1 * 32) ^ sw); kad2 = rb + ((cs + 2 * 32) ^ sw); kad3 = rb + ((cs + 3 * 32) ^ sw); }
#define KRD(dst, addr, OFF) asm volatile("ds_read_b128 %0, %1 offset:%2" : "=&v"(dst) : "v"(addr), "i"(OFF) : "memory")
#define LWAIT(N) do { asm volatile("s_waitcnt lgkmcnt(%0)" :: "n"(N) : "memory"); SBAR(); } while (0)
#define EXPP(P, r) do { P[r] = __builtin_amdgcn_exp2f(fmaf(P[r], SC_C, mC)); ps += P[r]; } while (0)
#define VGRP(D0, H, G) do { G##a = tr_read<v_rd_off(D0, 2 * (H), 0)>(vb); G##b = tr_read<v_rd_off(D0, 2 * (H), 1)>(vb); G##c = tr_read<v_rd_off(D0, 2 * (H) + 1, 0)>(vb); G##d = tr_read<v_rd_off(D0, 2 * (H) + 1, 1)>(vb); } while (0)
#define PK(L, H) (bf16x8){L[0], L[1], L[2], L[3], H[0], H[1], H[2], H[3]}
#define PK4(P, BASE, OUT) do { unsigned a0 = cvtpk(P[BASE + 0], P[BASE + 1]), a1 = cvtpk(P[BASE + 2], P[BASE + 3]);   \
    unsigned b0_ = cvtpk(P[BASE + 4], P[BASE + 5]), b1_ = cvtpk(P[BASE + 6], P[BASE + 7]);                              \
    auto r0 = __builtin_amdgcn_permlane32_swap(a0, b0_, false, false); auto r1 = __builtin_amdgcn_permlane32_swap(a1, b1_, false, false); \
    u32x4 w = {r0[0], r1[0], r0[1], r1[1]}; OUT = *reinterpret_cast<bf16x8*>(&w); } while (0)
#define MM(A, B, C) C = __builtin_amdgcn_mfma_f32_32x32x16_bf16(A, B, C, 0, 0, 0)
    for (int j = 0; j < NS; ++j) {
        const int b = j & 1, so = b * LDS_STAGE, vb = vb0 + so;
        bf16x8 kA0, kA1, kA2, kA3, kB0, kB1, kB2, kB3;
        s16x4 g0a, g0b, g0c, g0d, g1a, g1b, g1c, g1d, g2a, g2b, g2c, g2d, g3a, g3b, g3c, g3d;
        KRD(kA0, kad0 + so, 0); KRD(kA1, kad1 + so, 0); KRD(kA2, kad2 + so, 0); KRD(kA3, kad3 + so, 0);
        KRD(kB0, kad0 + so, 8192); KRD(kB1, kad1 + so, 8192); KRD(kB2, kad2 + so, 8192); KRD(kB3, kad3 + so, 8192);
        VGRP(0, 0, g0);
        if (j + 1 < NS) STAGE(b ^ 1, (j + 1) * 128);
        f32x16 p0 = {}, p1 = {};
        float ps = 0.f;
        SBAR();
        LWAIT(11); MM(kA0, qr[0], p0); SBAR();
        LWAIT(10); MM(kA1, qr[1], p0); SBAR();
        LWAIT(9);  MM(kA2, qr[2], p0); SBAR();
        LWAIT(8);  MM(kA3, qr[3], p0); SBAR();
        LWAIT(7);  MM(kB0, qr[0], p1); SBAR();
        LWAIT(6);  MM(kB1, qr[1], p1); SBAR(); EXPP(p0, 0); EXPP(p0, 1); EXPP(p0, 2); EXPP(p0, 3); SBAR();
        LWAIT(5);  MM(kB2, qr[2], p1); SBAR(); EXPP(p0, 4); EXPP(p0, 5); EXPP(p0, 6); EXPP(p0, 7); SBAR();
        LWAIT(4);  MM(kB3, qr[3], p1); SBAR(); EXPP(p0, 8); EXPP(p0, 9); EXPP(p0, 10); EXPP(p0, 11); SBAR();
        VGRP(1, 0, g1);
        EXPP(p0, 12); EXPP(p0, 13); EXPP(p0, 14); EXPP(p0, 15);
        bf16x8 pa0, pa1, pa2, pa3;
        PK4(p0, 0, pa0); PK4(p0, 8, pa1);
        SBAR();
        LWAIT(4); MM(pa0, PK(g0a, g0b), o0); SBAR(); EXPP(p1, 0); EXPP(p1, 1); SBAR();
        MM(pa1, PK(g0c, g0d), o0); SBAR(); EXPP(p1, 2); EXPP(p1, 3); SBAR();
        VGRP(2, 0, g2); SBAR();
        LWAIT(4); MM(pa0, PK(g1a, g1b), o1); SBAR(); EXPP(p1, 4); EXPP(p1, 5); SBAR();
        MM(pa1, PK(g1c, g1d), o1); SBAR(); EXPP(p1, 6); EXPP(p1, 7); SBAR();
        VGRP(3, 0, g3); SBAR();
        LWAIT(4); MM(pa0, PK(g2a, g2b), o2); SBAR(); EXPP(p1, 8); EXPP(p1, 9); SBAR();
        MM(pa1, PK(g2c, g2d), o2); SBAR(); EXPP(p1, 10); EXPP(p1, 11); SBAR();
        VGRP(0, 1, g0); SBAR();
        LWAIT(4); MM(pa0, PK(g3a, g3b), o3); SBAR(); EXPP(p1, 12); EXPP(p1, 13); SBAR();
        MM(pa1, PK(g3c, g3d), o3); SBAR(); EXPP(p1, 14); EXPP(p1, 15); SBAR();
        VGRP(1, 1, g1);
        l += ps;
        PK4(p1, 0, pa2); PK4(p1, 8, pa3);
        SBAR();
        LWAIT(4); MM(pa2, PK(g0a, g0b), o0); MM(pa3, PK(g0c, g0d), o0); SBAR();
        VGRP(2, 1, g2); SBAR();
        LWAIT(4); MM(pa2, PK(g1a, g1b), o1); MM(pa3, PK(g1c, g1d), o1); SBAR();
        VGRP(3, 1, g3); SBAR();
        LWAIT(4); MM(pa2, PK(g2a, g2b), o2); MM(pa3, PK(g2c, g2d), o2); SBAR();
        LWAIT(0); MM(pa2, PK(g3a, g3b), o3); MM(pa3, PK(g3c, g3d), o3); SBAR();
        LBARV();
    }
#undef KRD
#undef LWAIT
#undef EXPP
#undef VGRP
#undef PK
#undef PK4
#undef MM
#undef STAGE
#undef LBARV
#define SLOAD(x)
#define SWRITE(x)
#undef SLOAD
#undef SWRITE
    l += __shfl_xor(l, 32);
    const int pair = qg * 2 + s;
    if (kh == 1) {
#pragma unroll
        for (int r = 0; r < 16; ++r) { P1[((pair * 4 + 0) * 16 + r) * 64 + lane] = o0[r]; P1[((pair * 4 + 1) * 16 + r) * 64 + lane] = o1[r];
                                       P1[((pair * 4 + 2) * 16 + r) * 64 + lane] = o2[r]; P1[((pair * 4 + 3) * 16 + r) * 64 + lane] = o3[r]; }
        if (hi == 0) lpart[pair * 32 + r32] = l;
    }
    __syncthreads();
    float rli[16];
    if (kh == 0) {
#pragma unroll
        for (int r = 0; r < 16; ++r) { o0[r] += P1[((pair * 4 + 0) * 16 + r) * 64 + lane]; o1[r] += P1[((pair * 4 + 1) * 16 + r) * 64 + lane];
                                       o2[r] += P1[((pair * 4 + 2) * 16 + r) * 64 + lane]; o3[r] += P1[((pair * 4 + 3) * 16 + r) * 64 + lane]; }
        l += lpart[pair * 32 + r32];
        if (hi == 0) li_l[r32] = l;
        asm volatile("s_waitcnt lgkmcnt(0)" ::: "memory");
        const float wgt = s ? lam : 1.f;
#pragma unroll
        for (int r = 0; r < 16; ++r) rli[r] = wgt / li_l[crow(r, hi)];
        if (s == 1) {
#pragma unroll
            for (int r = 0; r < 16; ++r) { LAS float* row = OT + (qg * 32 + crow(r, hi)) * 128 + r32; row[0] = o0[r] * rli[r]; row[32] = o1[r] * rli[r]; row[64] = o2[r] * rli[r]; row[96] = o3[r] * rli[r]; }
        }
    }
    __syncthreads();
    if (kh == 0 && s == 0) {
#pragma unroll
        for (int r = 0; r < 16; ++r) { LAS float* row = OT + (qg * 32 + crow(r, hi)) * 128 + r32;
            row[0] = o0[r] * rli[r] - row[0]; row[32] = o1[r] * rli[r] - row[32]; row[64] = o2[r] * rli[r] - row[64]; row[96] = o3[r] * rli[r] - row[96]; }
    }
    __syncthreads();
    const float g0 = subg[2 * lane], g1 = subg[2 * lane + 1];
#pragma unroll
    for (int i = 0; i < 8; ++i) { const int row = wave * 8 + i;
        const float x0 = OT[row * 128 + 2 * lane], x1 = OT[row * 128 + 2 * lane + 1];
        const float ss = wave_sum(x0 * x0 + x1 * x1);
        const float rs = rsqrtf(ss * (1.f / 128.f) + EPS) * (1.f - lam_init);
        *(unsigned*)(A2o + (size_t)row * 1024 + 2 * lane) = pk2(x0 * rs * g0, x1 * rs * g1); }
    __syncthreads();
}
#undef KSWZ
#undef SBAR
}

__device__ __forceinline__ void phase_attn(const AV a, int l, LAS unsigned char* lds) {
    unsigned char* ws = a.ws_();
    const int G = gridDim.x;
    const float lam = ((const float*)(ws + WS_LAM))[l * 2], lam_init = ((const float*)(ws + WS_LAM))[l * 2 + 1];
    const float* kmax = (const float*)(ws + WS_KMAX) + l * 256;
    for (int it = blockIdx.x; it < 512; it += G) {
        int r0, kbase, nk, h, seq;
        if (it < 256) { const int b = it >> 7, qb = it & 31; h = (it >> 5) & 3; r0 = NCTX + b * 2048 + qb * 64; kbase = NCTX + b * 2304; nk = 2304; seq = 16 + b; }
        else { const int i2 = it - 256, b = i2 >> 4, qb = i2 & 3; h = (i2 >> 2) & 3; r0 = b * 256 + qb * 64; kbase = b * 256; nk = 256; seq = b; }
        att::attn_unit((const bf16_t*)(ws + WS_Q) + (size_t)r0 * 512 + h * 128, (const bf16_t*)(ws + WS_K) + (size_t)kbase * 512 + h * 128,
                       (const bf16_t*)(ws + WS_V) + (size_t)kbase * 512 + h * 128, nk, kmax[seq * 8 + h * 2], kmax[seq * 8 + h * 2 + 1],
                       lam, lam_init, a.in[16] + l * 128, (bf16_t*)(ws + WS_A2) + (size_t)r0 * D + h * 128, lds, a, l, r0 + 16 * h);
    }
}

template <int L>
__device__ __forceinline__ void layer_body(const AV a, LAS unsigned char* lds, const XcdBarrier& bar) {
    int tid_ = threadIdx.x; asm volatile("" : "+v"(tid_));
    const int lane = tid_ & 63, wave = __builtin_amdgcn_readfirstlane(tid_ >> 6);
    const int G = gridDim.x, bx = blockIdx.x;
    const int vcu = (G % 8 == 0) ? (bx % 8) * (G / 8) + bx / 8 : bx;
    const int gw = vcu * NWAVES + wave, NGW = G * NWAVES;
    constexpr int l = L;
    step_cache_rows(a, l, lane, gw, NGW);
    { unsigned char* ws = a.ws_();
      pg8::Gemm g{(const bf16_t*)(ws + WS_XA), (const bf16_t*)(ws + WS_WIN) + (size_t)l * DIN * D, NTOK, DIN, D}; pg8::HalfOrderMix S; S.init(NTOK, DIN, G, bx);
      pg8::EpiInProj<1> E{l, a.in[10] + l * 64, a.in[11] + l * 64, (const float*)(ws + WS_ROPE), (bf16_t*)(ws + WS_Q), (bf16_t*)(ws + WS_K), (bf16_t*)(ws + WS_V), (bf16_t*)(ws + WS_BG), (bf16_t*)(ws + WS_P), a.out_(), (unsigned*)(ws + WS_KMAX),
                        (const float*)(ws + WS_ROWSS) + (size_t)(l * 2) * RS_STRIDE, (const float*)(ws + WS_BIAS1) + (size_t)l * 3 * DIN};
      pg8::gemm_phase_h<pg8::EpiInProj<1>, pg8::HalfOrderMix>(lds, g, S, E);
    }
    xcd_barrier(bar);
    phase_attn(a, l, lds);
    xcd_barrier(bar);
    { unsigned char* ws = a.ws_(); const float* mod = (const float*)(ws + WS_MOD) + (size_t)l * 3 * NMOD;
      pg8::Gemm g{(const bf16_t*)(ws + WS_A2), (const bf16_t*)(ws + WS_WOUT) + (size_t)l * D * D, NTOK, D, D}; pg8::HalfOrder S; S.init(NTOK, D, G, bx);
      pg8::EpiRes<1, l == 0 ? 0 : 1, 1> E{a.in[0], a.in[1], (bf16_t*)(ws + WS_XR), nullptr, mod + 2 * D, (bf16_t*)(ws + WS_XA), a.in[20] + l * D, mod + 4 * D, (float*)(ws + WS_ROWSS) + (size_t)(l * 2 + 1) * RS_STRIDE};
      pg8::gemm_phase_h<pg8::EpiRes<1, l == 0 ? 0 : 1, 1>, pg8::HalfOrder>(lds, g, S, E);
    }
    xcd_barrier(bar);
    { unsigned char* ws = a.ws_();
      pg8::Gemm g{(const bf16_t*)(ws + WS_XA), (const bf16_t*)(ws + WS_WUP) + (size_t)l * DUP * D, 34 * 256, DUP, D}; pg8::OrderUp S; S.init(34 * 256, DUP, G, bx);
      pg8::EpiSwiglu E{a.in[22] + (size_t)l * 3 * DUP, (bf16_t*)(ws + WS_ACT), (LAS float*)(lds + EDGE_OFF), (const float*)(ws + WS_ROWSS) + (size_t)(l * 2 + 1) * RS_STRIDE, (const float*)(ws + WS_BIAS2) + (size_t)l * 3 * DUP};
      pg8::gemm_phase<pg8::EpiSwiglu, pg8::OrderUp, true, true>(lds, g, S, E);
    }
    xcd_barrier(bar);
    { unsigned char* ws = a.ws_(); const float* mod = (const float*)(ws + WS_MOD) + (size_t)l * 3 * NMOD;
      pg8::Gemm g{(const bf16_t*)(ws + WS_ACT), (const bf16_t*)(ws + WS_WDN) + (size_t)l * D * DFF, NTOK, D, DFF}; pg8::HalfOrder S; S.init(NTOK, D, G, bx);
      const float* modn = (const float*)(ws + WS_MOD) + (size_t)(l + 1) * 3 * NMOD;
      pg8::EpiRes<1, 1, l == 0 ? 1 : 0> E{nullptr, nullptr, (bf16_t*)(ws + WS_XR), a.out_(), mod + 5 * D, l == 0 ? (bf16_t*)(ws + WS_XA) : nullptr, a.in[8] + (l + 1) * D, modn + D, (float*)(ws + WS_ROWSS) + (size_t)((l + 1) * 2) * RS_STRIDE};
      pg8::gemm_phase_h<pg8::EpiRes<1, 1, l == 0 ? 1 : 0>, pg8::HalfOrder>(lds, g, S, E);
    }
}

__global__ void __launch_bounds__(512, 2) mk_fwd(Args args_unused) {
    const AV a{};
    extern __shared__ __attribute__((aligned(16))) unsigned char lds_raw[];
    LAS unsigned char* lds = (LAS unsigned char*)lds_raw;
    volatile LAS unsigned* MISC = (volatile LAS unsigned*)(lds + MISC_OFF);
    const int tid = threadIdx.x, lane = tid & 63, wave = __builtin_amdgcn_readfirstlane(tid >> 6);
    const int G = gridDim.x, bx = blockIdx.x;
    const int vcu = (G % 8 == 0) ? (bx % 8) * (G / 8) + bx / 8 : bx;
    const int gw = vcu * NWAVES + wave, NGW = G * NWAVES;
    unsigned char* ws = a.ws_();
    for (int u = tid; u < 64; u += 512) MISC[u] = 0u;
    __syncthreads();
    XcdBarrier bar = xcd_barrier_post((unsigned*)(ws + WS_BAR) + 4096, MISC + 8);

    phase_prologue(a, lds, tid, lane, wave, vcu, G);
    xcd_barrier(bar);
    { int t_ = threadIdx.x; asm volatile("" : "+v"(t_)); phase_prep(a, t_ & 63, vcu * NWAVES + __builtin_amdgcn_readfirstlane(t_ >> 6), G * NWAVES);
    }
    xcd_barrier(bar);
    layer_body<0>(a, lds, bar);
    xcd_barrier(bar);
    layer_body<1>(a, lds, bar);
}

extern "C" void kernel_launch(void* const* d_in, const int* in_sizes, int n_in, void* d_out, int out_size, void* d_ws, size_t ws_size, hipStream_t stream) {
    static int grid = 0;
    if (grid == 0) {
        int dev = 0, cus = 0, per_cu = 0;
        if (hipGetDevice(&dev) != hipSuccess || hipDeviceGetAttribute(&cus, hipDeviceAttributeMultiprocessorCount, dev) != hipSuccess) { fprintf(stderr, "kernel_launch: device query failed\n"); grid = -1; return; }
        if (hipFuncSetAttribute((const void*)mk_fwd, hipFuncAttributeMaxDynamicSharedMemorySize, LDS_BYTES) != hipSuccess) { fprintf(stderr, "kernel_launch: hipFuncSetAttribute failed\n"); grid = -1; return; }
        if (hipOccupancyMaxActiveBlocksPerMultiprocessor(&per_cu, (const void*)mk_fwd, NWAVES * 64, LDS_BYTES) != hipSuccess || per_cu < 1) { fprintf(stderr, "kernel_launch: occupancy query failed (%d)\n", per_cu); (void)hipGetLastError(); per_cu = 1; }
        if (per_cu > 1) per_cu = 1;
        grid = cus * per_cu;
    }
    if (grid < 0) return;
    (void)hipMemsetAsync((char*)d_ws + WS_BAR + 16384, 0, 16384, stream);
    Args a{};
    for (int i = 0; i < 24; ++i) a.in[i] = (const float*)d_in[i];
    a.out = (float*)d_out; a.ws = (unsigned char*)d_ws;
    void* args[] = {&a};
    hipError_t e = hipLaunchCooperativeKernel((const void*)mk_fwd, dim3(grid), dim3(NWAVES * 64), args, LDS_BYTES, stream);
    if (e != hipSuccess) fprintf(stderr, "kernel_launch: cooperative launch failed: %s (grid %d)\n", hipGetErrorString(e), grid);
}
```

```cpp
#include <hip/hip_runtime.h>
#include <hip/hip_cooperative_groups.h>
#include <cstdio>
#include <cstdint>
#include <math.h>
namespace cg = cooperative_groups;
#define GAS __attribute__((address_space(1)))
#define LAS __attribute__((address_space(3)))
namespace pg8 {
#define PG8_LAS __attribute__((address_space(3)))
typedef unsigned short bf16_t;
typedef short bf16x8 __attribute__((ext_vector_type(8)));
typedef float f32x4 __attribute__((ext_vector_type(4)));
typedef unsigned u32x4 __attribute__((ext_vector_type(4)));
constexpr int BM = 256, BK = 64, HALF = 128, HTB = HALF * BK * 2  , STAGE_BYTES = 8 * HTB, NXCD = 8, WGM = 8;

__host__ __device__ __forceinline__ int lds_byte(int r, int c) { const int st = (r >> 4) * 2 + (c >> 5), rr = r & 15, cc = c & 31, ob = rr * 64 + cc * 2; return st * 1024 + (ob ^ (((ob >> 9) & 1) << 5)); }
__host__ __device__ __forceinline__ void stage_rc(int b, int& R, int& C) { const int st = b / 1024, sb = b % 1024, swz = sb ^ (((sb >> 9) & 1) << 5); R = (st >> 1) * 16 + swz / 64; C = (st & 1) * 32 + (swz % 64) / 2; }
__host__ __device__ __forceinline__ int perm32(int rho) { const int n = rho >> 4, i = rho & 15; return 8 * (i >> 2) + 4 * n + (i & 3); }

struct Unit { int pm, pn; };
struct Gemm { const bf16_t* A; const bf16_t* Bt; int M, N, K; };

struct StaticOrder {
    int nM, nN, nwg, G, c;
    __host__ __device__ void init(int M, int N, int G_, int c_) { nM = M / BM; nN = N / BM; nwg = nM * nN; G = G_; c = c_; }
    __host__ __device__ bool next(int i, Unit& u) const {
        const long L = (long)i * G + c; if (L >= nwg) return false;
        int wgid = (int)L; { const int q = nwg / NXCD, r = nwg % NXCD, xcd = wgid % NXCD, off = wgid / NXCD; wgid = (xcd < r ? xcd * (q + 1) : r * (q + 1) + (xcd - r) * q) + off; }
        const int nig = WGM * nN, gid = wgid / nig, fm = gid * WGM, gsz = (nM - fm) < WGM ? (nM - fm) : WGM;
        u.pm = fm + ((wgid % nig) % gsz); u.pn = (wgid % nig) / gsz; return true;
    }
    __device__ __forceinline__ int arow(int pm) const { return pm * BM; }
    __device__ __forceinline__ void a_ready(const Unit&) const {}
    __device__ __forceinline__ void done(const Unit&) const {}
};
struct OrderUp : StaticOrder {
    __device__ __forceinline__ int arow(int pm) const { return pm < 16 ? pm * BM : 4096 + ((pm - 16) / 9) * 2048 + ((pm - 16) % 9) * 254 - 1; }
};

__device__ __forceinline__ unsigned cvt_pk_bf16(float lo, float hi) { unsigned r; asm volatile("v_cvt_pk_bf16_f32 %0, %1, %2" : "=v"(r) : "v"(lo), "v"(hi)); return r; }
__device__ __forceinline__ float xsum16(float v) { const auto r = __builtin_amdgcn_permlane16_swap(__float_as_uint(v), __float_as_uint(v), false, false); return __uint_as_float(r[0]) + __uint_as_float(r[1]); }
__device__ __forceinline__ float xsum32(float v) { const auto r = __builtin_amdgcn_permlane32_swap(__float_as_uint(v), __float_as_uint(v), false, false); return __uint_as_float(r[0]) + __uint_as_float(r[1]); }
template <int CTRL> __device__ __forceinline__ float dppf(float v) { return __uint_as_float((unsigned)__builtin_amdgcn_update_dpp(0, (int)__float_as_uint(v), CTRL, 0xf, 0xf, true)); }
__device__ __forceinline__ float rowsum16(float v) { v += dppf<0xB1>(v); v += dppf<0x4E>(v); v += dppf<0x141>(v); v += dppf<0x140>(v); return v; }
__device__ __forceinline__ u32x4 pair16(f32x4 v0, f32x4 v1) {
    const unsigned ax = cvt_pk_bf16(v0[0], v0[1]), ay = cvt_pk_bf16(v0[2], v0[3]), bx = cvt_pk_bf16(v1[0], v1[1]), by = cvt_pk_bf16(v1[2], v1[3]);
    const auto rx = __builtin_amdgcn_permlane16_swap(ax, bx, false, false); const auto ry = __builtin_amdgcn_permlane16_swap(ay, by, false, false);
    return (u32x4){rx[0], ry[0], rx[1], ry[1]};
}
__device__ __forceinline__ int pair16_col(int fq) { return 16 * (fq & 1) + 8 * (fq >> 1); }
__device__ __forceinline__ void unpair16(u32x4 q, f32x4& v0, f32x4& v1) {
    const auto rx = __builtin_amdgcn_permlane16_swap(q[0], q[2], false, false); const auto ry = __builtin_amdgcn_permlane16_swap(q[1], q[3], false, false);
    v0 = (f32x4){__uint_as_float(rx[0] << 16), __uint_as_float(rx[0] & 0xffff0000u), __uint_as_float(ry[0] << 16), __uint_as_float(ry[0] & 0xffff0000u)};
    v1 = (f32x4){__uint_as_float(rx[1] << 16), __uint_as_float(rx[1] & 0xffff0000u), __uint_as_float(ry[1] << 16), __uint_as_float(ry[1] & 0xffff0000u)};
}
template <int AI, int XIN, int OUT> struct EpiRes {
    static constexpr bool PERM = false, AFTER_DRAIN = false;
    const float* xin0; const float* xin1; bf16_t* xr; float* out; const float* gate;
    bf16_t* xa; const float* gnext; const float* scnext; float* rowss;
    struct Pre { u32x4 q[XIN == 1 ? AI : 1][4][2]; };
    __device__ __forceinline__ void pre(const Unit& u, int wr, int wc, int fr, int fq, Pre& p) const {
        if (XIN == 1) { const int r0 = u.pm * (AI * HALF), colp = u.pn * BM + wc * 32 + pair16_col(fq);
#pragma unroll
            for (int ai = 0; ai < AI; ++ai)
#pragma unroll
                for (int m = 0; m < 4; ++m)
#pragma unroll
                    for (int bj = 0; bj < 2; ++bj) p.q[ai][m][bj] = *(const u32x4*)(xr + (size_t)(r0 + ai * HALF + wr * 64 + m * 16 + fr) * 1024 + colp + bj * HALF); }
    }
    __device__ __forceinline__ void operator()(const f32x4 (&acc)[AI][2][4][2], const Unit& u, int wr, int wc, int fr_, int fq_, const Pre& pre) const {
        int fr = fr_, fq = fq_; asm volatile("" : "+v"(fr), "+v"(fq));
        const int r0 = u.pm * (AI * HALF);
        const float* xb = (r0 < 4096) ? xin0 + (size_t)r0 * 1024 : xin1 + (size_t)(r0 - 4096) * 1024;
        const int grp = (r0 < 4096) ? 0 : 1 + ((r0 - 4096) >> 11);
        const int col0 = u.pn * BM + wc * 32 + 4 * fq, colp = u.pn * BM + wc * 32 + pair16_col(fq);
        f32x4 gv[2][2], gs[2][2];
#pragma unroll
        for (int bj = 0; bj < 2; ++bj)
#pragma unroll
            for (int n = 0; n < 2; ++n) { const int c = col0 + bj * HALF + n * 16; gv[bj][n] = *(const f32x4*)(gate + (size_t)grp * 6144 + c);
                if (xa) gs[bj][n] = *(const f32x4*)(gnext + c) * (*(const f32x4*)(scnext + (size_t)grp * 6144 + c) + 1.f); else gs[bj][n] = gv[bj][n]; }
#pragma unroll
        for (int ai = 0; ai < AI; ++ai)
#pragma unroll
            for (int m = 0; m < 4; ++m) { const int rl = ai * HALF + wr * 64 + m * 16 + fr; float ssq = 0.f;
#pragma unroll
                for (int bj = 0; bj < 2; ++bj) { f32x4 xv[2], o[2], yv[2];
                    if (XIN == 0) { xv[0] = *(const f32x4*)(xb + (size_t)rl * 1024 + col0 + bj * HALF); xv[1] = *(const f32x4*)(xb + (size_t)rl * 1024 + col0 + bj * HALF + 16); }
                    else unpair16(pre.q[ai][m][bj], xv[0], xv[1]);
#pragma unroll
                    for (int n = 0; n < 2; ++n) { o[n] = xv[n] + gv[bj][n] * acc[ai][bj][m][n];
                        if (OUT == 0) *(f32x4*)(out + (size_t)(r0 + rl) * 1024 + col0 + bj * HALF + n * 16) = o[n];
                        if (xa) { ssq += (o[n][0] * o[n][0] + o[n][1] * o[n][1]) + (o[n][2] * o[n][2] + o[n][3] * o[n][3]); yv[n] = o[n] * gs[bj][n]; } }
                    if (OUT == 1) *(u32x4*)(xr + (size_t)(r0 + rl) * 1024 + colp + bj * HALF) = pair16(o[0], o[1]);
                    if (xa) *(u32x4*)(xa + (size_t)(r0 + rl) * 1024 + colp + bj * HALF) = pair16(yv[0], yv[1]); }
                if (xa) { ssq = xsum32(xsum16(ssq)); if (fq == 0) atomicAdd(rowss + r0 + rl, ssq); } }
    }
};
typedef _Float16 h2_t __attribute__((ext_vector_type(2)));
template <int CTRL> __device__ __forceinline__ h2_t dpph(h2_t old, h2_t src) {
    return __builtin_bit_cast(h2_t, __builtin_amdgcn_update_dpp(__builtin_bit_cast(int, old), __builtin_bit_cast(int, src), CTRL, 0xf, 0xf, false)); }
__device__ __forceinline__ h2_t pkh(float a, float b) { return __builtin_bit_cast(h2_t, __builtin_amdgcn_cvt_pkrtz(a, b)); }
struct EpiSwiglu {
    static constexpr bool PERM = true, AFTER_DRAIN = false;
    const float* cw; bf16_t* act; PG8_LAS float* edge; const float* rowss; const float* bias;
    PG8_LAS float* sbr;
    __device__ __forceinline__ float stash_load(const Unit& u, int tid) const {
        int row0; if (u.pm < 16) row0 = u.pm * 256; else { const int b = (u.pm - 16) / 9, i = (u.pm - 16) % 9; row0 = 4096 + 2048 * b + 254 * i - 1; }
        const int grp = u.pm < 16 ? 0 : 1 + (u.pm - 16) / 9;
        return tid < 256 ? bias[(size_t)grp * 5632 + u.pn * BM + tid] : rowss[row0 + tid - 256];
    }
    __device__ __forceinline__ void stash_store(float v, int tid) const { sbr[tid] = v; }
    __device__ __forceinline__ void operator()(f32x4 (&acc)[2][2][4][2], const Unit& u, int wr, int wc, int fr_, int fq_) const {
        int fr = fr_, fq = fq_; asm volatile("" : "+v"(fr), "+v"(fq));
        int row0, vlo = 0, vhi = 256, olo = 0, ohi = 256;
        if (u.pm < 16) row0 = u.pm * 256;
        else { const int b = (u.pm - 16) / 9, i = (u.pm - 16) % 9, t0 = 254 * i - 1; row0 = 4096 + 2048 * b + t0; vlo = (i == 0) ? 1 : 0; vhi = (2048 - t0) < 256 ? (2048 - t0) : 256; olo = 1; ohi = vhi < 255 ? vhi : 255; }
        h2_t U[2][2][4][2][2];
        {
            const int grp = u.pm < 16 ? 0 : 1 + (u.pm - 16) / 9;
            const bool need_mask = vlo > 0 || vhi < 256;
            f32x4 bv[2][2];
#pragma unroll
            for (int bj = 0; bj < 2; ++bj)
#pragma unroll
                for (int n = 0; n < 2; ++n) bv[bj][n] = *(const PG8_LAS f32x4*)(sbr + bj * HALF + wc * 32 + 8 * fq + 4 * n);
            if (!need_mask) {
#pragma unroll
                for (int ai = 0; ai < 2; ++ai)
#pragma unroll
                    for (int m = 0; m < 4; ++m) { const float rs = __builtin_amdgcn_rsqf(sbr[256 + ai * HALF + wr * 64 + m * 16 + fr] * (1.f / 1024.f) + 1e-6f);
#pragma unroll
                        for (int bj = 0; bj < 2; ++bj)
#pragma unroll
                            for (int n = 0; n < 2; ++n) { const f32x4 v = acc[ai][bj][m][n] * rs + bv[bj][n]; U[ai][bj][m][n][0] = pkh(v[0], v[1]); U[ai][bj][m][n][1] = pkh(v[2], v[3]); } }
            } else {
#pragma unroll
                for (int ai = 0; ai < 2; ++ai)
#pragma unroll
                    for (int m = 0; m < 4; ++m) { const int rho = ai * HALF + wr * 64 + m * 16 + fr; const bool ok = rho >= vlo && rho < vhi;
                        const float rs = __builtin_amdgcn_rsqf(sbr[256 + rho] * (1.f / 1024.f) + 1e-6f);
#pragma unroll
                        for (int bj = 0; bj < 2; ++bj)
#pragma unroll
                            for (int n = 0; n < 2; ++n) { f32x4 v = acc[ai][bj][m][n] * rs + bv[bj][n]; v[0] = ok ? v[0] : 0.f; v[1] = ok ? v[1] : 0.f; v[2] = ok ? v[2] : 0.f; v[3] = ok ? v[3] : 0.f;
                                U[ai][bj][m][n][0] = pkh(v[0], v[1]); U[ai][bj][m][n][1] = pkh(v[2], v[3]); } }
            }
        }
#pragma unroll
        for (int ai = 0; ai < 2; ++ai) { const int seg = ai * 2 + wr;
#pragma unroll
            for (int bj = 0; bj < 2; ++bj)
#pragma unroll
                for (int n = 0; n < 2; ++n) {
                    if (fr == 0)  { PG8_LAS h2_t* p = (PG8_LAS h2_t*)(edge + ((seg * 2 + 0) * 4 + wc) * 64 + (bj * 2 + n) * 16 + fq * 4); p[0] = U[ai][bj][0][n][0]; p[1] = U[ai][bj][0][n][1]; }
                    if (fr == 15) { PG8_LAS h2_t* p = (PG8_LAS h2_t*)(edge + ((seg * 2 + 1) * 4 + wc) * 64 + (bj * 2 + n) * 16 + fq * 4); p[0] = U[ai][bj][3][n][0]; p[1] = U[ai][bj][3][n][1]; } } }
        asm volatile("s_waitcnt lgkmcnt(0)" ::: "memory"); __builtin_amdgcn_s_barrier(); asm volatile("" ::: "memory");
        const int cj = u.pn * HALF + wc * 32 + 8 * fq;
        const h2_t zero2 = {(_Float16)0.f, (_Float16)0.f};
        uint2 keep[2][4];
#pragma unroll
        for (int n = 0; n < 2; ++n) {
            h2_t w[3][2][2];
#pragma unroll
            for (int tp = 0; tp < 3; ++tp)
#pragma unroll
                for (int bj = 0; bj < 2; ++bj) { const f32x4 wf = *(const f32x4*)(cw + tp * 5632 + bj * 2816 + cj + 4 * n); w[tp][bj][0] = pkh(wf[0], wf[1]); w[tp][bj][1] = pkh(wf[2], wf[3]); }
#pragma unroll
            for (int ai = 0; ai < 2; ++ai) { const int seg = ai * 2 + wr;
                h2_t above[2][2], below[2][2];
#pragma unroll
                for (int bj = 0; bj < 2; ++bj)
#pragma unroll
                    for (int p = 0; p < 2; ++p) {
                        above[bj][p] = seg > 0 ? ((const PG8_LAS h2_t*)(edge + (((seg - 1) * 2 + 1) * 4 + wc) * 64 + (bj * 2 + n) * 16 + fq * 4))[p] : zero2;
                        below[bj][p] = seg < 3 ? ((const PG8_LAS h2_t*)(edge + (((seg + 1) * 2 + 0) * 4 + wc) * 64 + (bj * 2 + n) * 16 + fq * 4))[p] : zero2; }
#pragma unroll
                for (int m = 0; m < 4; ++m) { const int rho = ai * HALF + wr * 64 + m * 16 + fr;
                    h2_t c[2][2];
#pragma unroll
                    for (int bj = 0; bj < 2; ++bj)
#pragma unroll
                        for (int p = 0; p < 2; ++p) { const h2_t cur = U[ai][bj][m][n][p];
                            const h2_t oldu = (m > 0) ? dpph<0x121>(U[ai][bj][m > 0 ? m - 1 : 0][n][p], U[ai][bj][m > 0 ? m - 1 : 0][n][p]) : above[bj][p];
                            const h2_t up = dpph<0x111>(oldu, cur);
                            const h2_t oldd = (m < 3) ? dpph<0x12F>(U[ai][bj][m < 3 ? m + 1 : 3][n][p], U[ai][bj][m < 3 ? m + 1 : 3][n][p]) : below[bj][p];
                            const h2_t dn = dpph<0x101>(oldd, cur);
                            c[bj][p] = w[1][bj][p] * cur + w[0][bj][p] * up + w[2][bj][p] * dn; }
                    float r[4];
#pragma unroll
                    for (int e = 0; e < 4; ++e) { const float x = (float)c[0][e >> 1][e & 1], y = (float)c[1][e >> 1][e & 1];
                        r[e] = x * __builtin_amdgcn_rcpf(1.f + __builtin_amdgcn_exp2f(-1.4426950408889634f * x)) * y; }
                    uint2 o; o.x = cvt_pk_bf16(r[0], r[1]); o.y = cvt_pk_bf16(r[2], r[3]);
                    if (n == 0) keep[ai][m] = o;
                    else { u32x4 q; q.x = keep[ai][m].x; q.y = keep[ai][m].y; q.z = o.x; q.w = o.y;
                        if (rho >= olo && rho < ohi) *(u32x4*)(act + (size_t)(row0 + rho) * 2816 + cj) = q; } }
            }
        }
    }
};
template <class Epi, class Sched, bool ALIGN_EPI = false, bool SP2 = false>
__device__ __forceinline__ void gemm_phase(PG8_LAS unsigned char* lds, const Gemm g, const Sched& S, const Epi& E) {
    int tid_ = threadIdx.x; asm volatile("" : "+v"(tid_));
    const int tid = tid_, wid = __builtin_amdgcn_readfirstlane(tid >> 6), lane = tid & 63, wr = wid >> 2, wc = wid & 3, fr = lane & 15, fq = lane >> 4;
    const int K = g.K, nt = K / BK;
    unsigned voffA[2], voffB[2];
#pragma unroll
    for (int i = 0; i < 2; ++i) { int R, C; stage_rc(tid * 16 + i * 8192, R, C); const int Rb = Epi::PERM ? ((R & ~31) + perm32(R & 31)) : R;
        voffA[i] = (unsigned)(R * K + C) * 2u; voffB[i] = (unsigned)(Rb * K + C) * 2u; }
    const size_t kstep = (size_t)(BK * 2);
    const size_t hstep = (size_t)HALF * K * 2;
    const size_t tstep = 2 * hstep;
    const unsigned ldsw = (unsigned)wid * 1024u;
    const int aoff = lds_byte(wr * 64 + fr, fq * 8), boff = lds_byte(wc * 32 + fr, fq * 8);
#define PG8_SA(b, h) (((b) * 2 + (h)) * HTB)
#define PG8_SB(b, h) ((4 + (b) * 2 + (h)) * HTB)
#define PG8_STAGE(bufoff, gbase, voff) do { _Pragma("unroll") for (int _i = 0; _i < 2; ++_i) \
        __builtin_amdgcn_global_load_lds((const unsigned*)((const char*)(gbase) + (voff)[_i]), (PG8_LAS unsigned*)(lds + (bufoff) + ldsw + _i * 8192), 16, 0, 0); } while (0)
#define PG8_LDA(dst, b, h) do { _Pragma("unroll") for (int m = 0; m < 4; ++m) _Pragma("unroll") for (int k = 0; k < 2; ++k) dst[m][k] = *(const PG8_LAS bf16x8*)(lds + PG8_SA(b, h) + aoff + m * 2048 + k * 1024); } while (0)
#define PG8_LDB(dst, b, h) do { _Pragma("unroll") for (int n = 0; n < 2; ++n) _Pragma("unroll") for (int k = 0; k < 2; ++k) dst[n][k] = *(const PG8_LAS bf16x8*)(lds + PG8_SB(b, h) + boff + n * 2048 + k * 1024); } while (0)
#define PG8_MMA(ai, bj, At, Bt) do { __builtin_amdgcn_s_setprio(1); _Pragma("unroll") for (int m = 0; m < 4; ++m) _Pragma("unroll") for (int n = 0; n < 2; ++n) _Pragma("unroll") for (int k = 0; k < 2; ++k) \
        acc[ai][bj][m][n] = __builtin_amdgcn_mfma_f32_16x16x32_bf16(Bt[n][k], At[m][k], acc[ai][bj][m][n], 0, 0, 0); __builtin_amdgcn_s_setprio(0); } while (0)
#define PG8_WAIT_V(n) asm volatile("s_waitcnt vmcnt(" #n ")" ::: "memory")
#define PG8_WAIT_L(n) asm volatile("s_waitcnt lgkmcnt(" #n ")" ::: "memory")
#define PG8_BAR __builtin_amdgcn_s_barrier()
#define PG8_SCHED __builtin_amdgcn_sched_barrier(0)
    Unit cur, nxt; int ui = 0;
    if (!S.next(0, cur)) return;
    f32x4 acc[2][2][4][2];
#pragma unroll
    for (int a = 0; a < 2; ++a)
#pragma unroll
        for (int b = 0; b < 2; ++b)
#pragma unroll
            for (int m = 0; m < 4; ++m)
#pragma unroll
                for (int n = 0; n < 2; ++n) acc[a][b][m][n] = (f32x4){0.f, 0.f, 0.f, 0.f};
    bf16x8 At[4][2], B0[2][2], B1[2][2];
    const char* cA = (const char*)g.A + (size_t)S.arow(cur.pm) * (size_t)K * 2; const char* cB = (const char*)g.Bt + (size_t)cur.pn * tstep;
    E.stash_store(E.stash_load(cur, tid), tid);
    S.a_ready(cur);
    if constexpr (SP2) {
        PG8_STAGE(PG8_SB(0, 0), cB, voffB); PG8_STAGE(PG8_SB(0, 1), cB + hstep, voffB); PG8_STAGE(PG8_SA(0, 0), cA, voffA); PG8_STAGE(PG8_SA(0, 1), cA + hstep, voffA);
        if (wr == 1) PG8_BAR;
        PG8_WAIT_V(2); PG8_BAR;
        PG8_STAGE(PG8_SB(1, 0), cB + kstep, voffB); PG8_STAGE(PG8_SA(1, 0), cA + kstep, voffA); PG8_STAGE(PG8_SB(1, 1), cB + hstep + kstep, voffB);
        PG8_WAIT_V(6); PG8_BAR;
    } else {
        PG8_STAGE(PG8_SB(0, 0), cB, voffB); PG8_STAGE(PG8_SA(0, 0), cA, voffA); PG8_STAGE(PG8_SB(0, 1), cB + hstep, voffB); PG8_STAGE(PG8_SA(0, 1), cA + hstep, voffA);
        if (wr == 1) PG8_BAR;
        PG8_WAIT_V(4); PG8_BAR;
        PG8_STAGE(PG8_SB(1, 0), cB + kstep, voffB); PG8_STAGE(PG8_SA(1, 0), cA + kstep, voffA); PG8_STAGE(PG8_SB(1, 1), cB + hstep + kstep, voffB);
        PG8_WAIT_V(6); PG8_BAR;
    }
    for (;;) {
        const bool has_next = S.next(ui + 1, nxt);
        const char* nA = has_next ? (const char*)g.A + (size_t)S.arow(nxt.pm) * (size_t)K * 2 : cA; const char* nB = has_next ? (const char*)g.Bt + (size_t)nxt.pn * tstep : cB;
        for (int t = 0; t < nt; t += 2) {
            const bool last = (t == nt - 2);
            const char* a1 = cA + (size_t)(t + 1) * kstep;
            const char* a2 = last ? nA : cA + (size_t)(t + 2) * kstep; const char* b2 = last ? nB : cB + (size_t)(t + 2) * kstep;
            const char* a3 = a2 + kstep; const char* b3 = b2 + kstep;
            if (last && has_next) S.a_ready(nxt);
            if constexpr (SP2) {
            PG8_LDB(B0, 0, 0); PG8_LDB(B1, 0, 1); PG8_SCHED; PG8_LDA(At, 0, 0); PG8_STAGE(PG8_SA(1, 1), a1 + hstep, voffA);
            PG8_WAIT_V(8); PG8_WAIT_L(0); PG8_BAR; PG8_MMA(0, 0, At, B0); PG8_MMA(0, 1, At, B1); PG8_BAR; PG8_SCHED;
            PG8_LDA(At, 0, 1); PG8_STAGE(PG8_SB(0, 0), b2, voffB); PG8_STAGE(PG8_SB(0, 1), b2 + hstep, voffB); PG8_STAGE(PG8_SA(0, 0), a2, voffA);
            PG8_WAIT_V(8); PG8_WAIT_L(0); PG8_BAR; PG8_MMA(1, 0, At, B0); PG8_MMA(1, 1, At, B1); PG8_BAR; PG8_SCHED;
            PG8_LDB(B0, 1, 0); PG8_LDB(B1, 1, 1); PG8_SCHED; PG8_LDA(At, 1, 0); PG8_STAGE(PG8_SA(0, 1), a2 + hstep, voffA);
            PG8_WAIT_V(8); PG8_WAIT_L(0); PG8_BAR; PG8_MMA(0, 0, At, B0); PG8_MMA(0, 1, At, B1); PG8_BAR; PG8_SCHED;
            PG8_LDA(At, 1, 1); PG8_STAGE(PG8_SB(1, 0), b3, voffB); PG8_STAGE(PG8_SB(1, 1), b3 + hstep, voffB); PG8_STAGE(PG8_SA(1, 0), a3, voffA);
            PG8_WAIT_V(8); PG8_WAIT_L(0); PG8_BAR; PG8_MMA(1, 0, At, B0); PG8_MMA(1, 1, At, B1); PG8_BAR; PG8_SCHED;
            } else {
            PG8_LDB(B0, 0, 0); PG8_SCHED; PG8_LDA(At, 0, 0); PG8_STAGE(PG8_SA(1, 1), a1 + hstep, voffA);
            PG8_WAIT_L(8); PG8_BAR; PG8_WAIT_L(0); PG8_MMA(0, 0, At, B0); PG8_BAR; PG8_SCHED;
            PG8_LDB(B1, 0, 1); PG8_STAGE(PG8_SB(0, 0), b2, voffB);
            PG8_BAR; PG8_WAIT_L(0); PG8_MMA(0, 1, At, B1); PG8_BAR;
            PG8_LDA(At, 0, 1); PG8_STAGE(PG8_SA(0, 0), a2, voffA);
            PG8_BAR; PG8_WAIT_L(0); PG8_MMA(1, 0, At, B0); PG8_BAR; PG8_SCHED;
            PG8_STAGE(PG8_SB(0, 1), b2 + hstep, voffB);
            PG8_WAIT_V(6); PG8_BAR; PG8_MMA(1, 1, At, B1); PG8_BAR;
            PG8_LDB(B0, 1, 0); PG8_SCHED; PG8_LDA(At, 1, 0); PG8_STAGE(PG8_SA(0, 1), a2 + hstep, voffA);
            PG8_WAIT_L(8); PG8_BAR; PG8_WAIT_L(0); PG8_MMA(0, 0, At, B0); PG8_BAR; PG8_SCHED;
            PG8_LDB(B1, 1, 1); PG8_STAGE(PG8_SB(1, 0), b3, voffB);
            PG8_BAR; PG8_WAIT_L(0); PG8_MMA(0, 1, At, B1); PG8_BAR;
            PG8_LDA(At, 1, 1); PG8_STAGE(PG8_SA(1, 0), a3, voffA);
            PG8_BAR; PG8_WAIT_L(0); PG8_MMA(1, 0, At, B0); PG8_BAR; PG8_SCHED;
            PG8_STAGE(PG8_SB(1, 1), b3 + hstep, voffB);
            PG8_WAIT_V(6); PG8_BAR; PG8_MMA(1, 1, At, B1); PG8_BAR;
            }
        }
        if constexpr (ALIGN_EPI) { if (wr == 0) PG8_BAR; }
        float stash_nx = 0.f; if (has_next) stash_nx = E.stash_load(nxt, tid);
        if constexpr (!Epi::AFTER_DRAIN) { E(acc, cur, wr, wc, fr, fq); S.done(cur); }
        if (!has_next) break;
        E.stash_store(stash_nx, tid);
#pragma unroll
        for (int a = 0; a < 2; ++a)
#pragma unroll
            for (int b = 0; b < 2; ++b)
#pragma unroll
                for (int m = 0; m < 4; ++m)
#pragma unroll
                    for (int n = 0; n < 2; ++n) acc[a][b][m][n] = (f32x4){0.f, 0.f, 0.f, 0.f};
        cur = nxt; cA = nA; cB = nB; ++ui;
        if constexpr (ALIGN_EPI) { if (wr == 1) PG8_BAR; }
    }
    PG8_WAIT_V(0);
    if constexpr (!ALIGN_EPI) { if (wr == 0) PG8_BAR; }
    PG8_BAR;
    if constexpr (Epi::AFTER_DRAIN) { E.fused(acc, cur, wr, wc, fr, fq, lds, wid, lane); S.done(cur); }
#undef PG8_SA
#undef PG8_SB
#undef PG8_STAGE
#undef PG8_LDA
#undef PG8_LDB
#undef PG8_MMA
#undef PG8_WAIT_V
#undef PG8_WAIT_L
#undef PG8_BAR
#undef PG8_SCHED
}
struct HalfOrder {
    int nM, nN, nwg, G, c;
    __host__ __device__ void init(int M, int N, int G_, int c_) { nM = M / HALF; nN = N / BM; nwg = nM * nN; G = G_; c = c_; }
    __host__ __device__ bool next(int i, Unit& u) const {
        const long L = (long)i * G + c; if (L >= nwg) return false;
        int wgid = (int)L; { const int q = nwg / NXCD, r = nwg % NXCD, xcd = wgid % NXCD, off = wgid / NXCD; wgid = (xcd < r ? xcd * (q + 1) : r * (q + 1) + (xcd - r) * q) + off; }
        const int nig = WGM * nN, gid = wgid / nig, fm = gid * WGM, gsz = (nM - fm) < WGM ? (nM - fm) : WGM;
        u.pm = fm + ((wgid % nig) % gsz); u.pn = (wgid % nig) / gsz; return true;
    }
    __device__ __forceinline__ int arow(int pm) const { return pm * HALF; }
};
struct HalfOrderMix : HalfOrder {
    __host__ __device__ bool next(int i, Unit& u) const { if (!HalfOrder::next(i, u)) return false; u.pm = (u.pm + 32 * i) % nM; return true; }
};
constexpr int PH_STG = 3 * HTB;
template <class Epi, class Sched, bool MMA_FIRST>
__device__ __forceinline__ void gemm_phase_h_impl(PG8_LAS unsigned char* lds, const Gemm g, const Sched& S, const Epi& E) {
    int tid_ = threadIdx.x; asm volatile("" : "+v"(tid_));
    const int tid = tid_, wid = __builtin_amdgcn_readfirstlane(tid >> 6), lane = tid & 63, wr = wid >> 2, wc = wid & 3, fr = lane & 15, fq = lane >> 4;
    const int K = g.K, nt = K / BK;
    unsigned voffA[2], voffB[2];
#pragma unroll
    for (int i = 0; i < 2; ++i) { int R, C; stage_rc(tid * 16 + i * 8192, R, C); const int Rb = Epi::PERM ? ((R & ~31) + perm32(R & 31)) : R;
        voffA[i] = (unsigned)(R * K + C) * 2u; voffB[i] = (unsigned)(Rb * K + C) * 2u; }
    const size_t kstep = (size_t)(BK * 2), hstep = (size_t)HALF * K * 2, tstepB = 2 * hstep;
    const unsigned ldsw = (unsigned)wid * 1024u;
    const int aoff = lds_byte(wr * 64 + fr, fq * 8), boff = lds_byte(wc * 32 + fr, fq * 8);
#define PH_STAGE(bufoff, gbase, voff) do { _Pragma("unroll") for (int _i = 0; _i < 2; ++_i) \
        __builtin_amdgcn_global_load_lds((const unsigned*)((const char*)(gbase) + (voff)[_i]), (PG8_LAS unsigned*)(lds + (bufoff) + ldsw + _i * 8192), 16, 0, 0); } while (0)
#define PH_STAGE3(so, ga, gb) do { PH_STAGE((so), ga, voffA); PH_STAGE((so) + HTB, gb, voffB); PH_STAGE((so) + 2 * HTB, (gb) + hstep, voffB); } while (0)
#define PH_LDALL(so, At, B0, B1) do { \
        _Pragma("unroll") for (int n = 0; n < 2; ++n) _Pragma("unroll") for (int k = 0; k < 2; ++k) B0[n][k] = *(const PG8_LAS bf16x8*)(lds + (so) + HTB + boff + n * 2048 + k * 1024); \
        _Pragma("unroll") for (int n = 0; n < 2; ++n) _Pragma("unroll") for (int k = 0; k < 2; ++k) B1[n][k] = *(const PG8_LAS bf16x8*)(lds + (so) + 2 * HTB + boff + n * 2048 + k * 1024); \
        _Pragma("unroll") for (int m = 0; m < 4; ++m) _Pragma("unroll") for (int k = 0; k < 2; ++k) At[m][k] = *(const PG8_LAS bf16x8*)(lds + (so) + aoff + m * 2048 + k * 1024); } while (0)
#define PH_MMA(bj, At, Bt) do { _Pragma("unroll") for (int m = 0; m < 4; ++m) _Pragma("unroll") for (int n = 0; n < 2; ++n) _Pragma("unroll") for (int k = 0; k < 2; ++k) \
        acc[0][bj][m][n] = __builtin_amdgcn_mfma_f32_16x16x32_bf16(Bt[n][k], At[m][k], acc[0][bj][m][n], 0, 0, 0); } while (0)
#define PH_SYNC6() do { __builtin_amdgcn_s_waitcnt(0x0076); asm volatile("" ::: "memory"); __builtin_amdgcn_s_barrier(); __builtin_amdgcn_sched_barrier(0); } while (0)
#define PH_SYNC0() do { __builtin_amdgcn_s_waitcnt(0x0070); asm volatile("" ::: "memory"); __builtin_amdgcn_s_barrier(); __builtin_amdgcn_sched_barrier(0); } while (0)
    Unit cur, nxt; int ui = 0;
    if (!S.next(0, cur)) return;
    f32x4 acc[1][2][4][2];
#pragma unroll
    for (int b = 0; b < 2; ++b)
#pragma unroll
        for (int m = 0; m < 4; ++m)
#pragma unroll
            for (int n = 0; n < 2; ++n) acc[0][b][m][n] = (f32x4){0.f, 0.f, 0.f, 0.f};
    bf16x8 Xa[4][2], Xb0[2][2], Xb1[2][2], Ya[4][2], Yb0[2][2], Yb1[2][2];
    const char* cA = (const char*)g.A + (size_t)S.arow(cur.pm) * (size_t)K * 2; const char* cB = (const char*)g.Bt + (size_t)cur.pn * tstepB;
    typename Epi::Pre pre; E.pre(cur, wr, wc, fr, fq, pre);
    int s0 = 0, s1 = PH_STG, s2 = 2 * PH_STG;
    PH_STAGE3(s0, cA, cB); PH_STAGE3(s1, cA + kstep, cB + kstep); PH_STAGE3(s2, cA + 2 * kstep, cB + 2 * kstep);
    PH_SYNC6();
    PH_LDALL(s0, Xa, Xb0, Xb1);
    __builtin_amdgcn_s_waitcnt(0xC07F);
    for (;;) {
        const bool has_next = S.next(ui + 1, nxt);
        const char* nA = has_next ? (const char*)g.A + (size_t)S.arow(nxt.pm) * (size_t)K * 2 : cA; const char* nB = has_next ? (const char*)g.Bt + (size_t)nxt.pn * tstepB : cB;
        for (int t = 0; t < nt; t += 2) {
            const int t3 = t + 3, t4 = t + 4;
            const char* a3 = t3 < nt ? cA + (size_t)t3 * kstep : nA + (size_t)(t3 - nt) * kstep; const char* b3 = t3 < nt ? cB + (size_t)t3 * kstep : nB + (size_t)(t3 - nt) * kstep;
            const char* a4 = t4 < nt ? cA + (size_t)t4 * kstep : nA + (size_t)(t4 - nt) * kstep; const char* b4 = t4 < nt ? cB + (size_t)t4 * kstep : nB + (size_t)(t4 - nt) * kstep;
            if constexpr (!MMA_FIRST) {
                PH_SYNC6();
                PH_STAGE3(s0, a3, b3);
                PH_LDALL(s1, Ya, Yb0, Yb1);
                __builtin_amdgcn_sched_barrier(0);
                __builtin_amdgcn_s_setprio(1); PH_MMA(0, Xa, Xb0); PH_MMA(1, Xa, Xb1); __builtin_amdgcn_s_setprio(0);
                PH_SYNC6();
                PH_STAGE3(s1, a4, b4);
                PH_LDALL(s2, Xa, Xb0, Xb1);
                __builtin_amdgcn_sched_barrier(0);
                __builtin_amdgcn_s_setprio(1); PH_MMA(0, Ya, Yb0); PH_MMA(1, Ya, Yb1); __builtin_amdgcn_s_setprio(0);
            } else {
                PH_SYNC6();
                __builtin_amdgcn_s_setprio(1); PH_MMA(0, Xa, Xb0); __builtin_amdgcn_s_setprio(0);
                __builtin_amdgcn_sched_barrier(0);
                PH_STAGE3(s0, a3, b3);
                PH_LDALL(s1, Ya, Yb0, Yb1);
                __builtin_amdgcn_sched_barrier(0);
                __builtin_amdgcn_s_setprio(1); PH_MMA(1, Xa, Xb1); __builtin_amdgcn_s_setprio(0);
                PH_SYNC6();
                __builtin_amdgcn_s_setprio(1); PH_MMA(0, Ya, Yb0); __builtin_amdgcn_s_setprio(0);
                __builtin_amdgcn_sched_barrier(0);
                PH_STAGE3(s1, a4, b4);
                PH_LDALL(s2, Xa, Xb0, Xb1);
                __builtin_amdgcn_sched_barrier(0);
                __builtin_amdgcn_s_setprio(1); PH_MMA(1, Ya, Yb1); __builtin_amdgcn_s_setprio(0);
            }
            { const int o0 = s0, o1 = s1; s0 = s2; s1 = o0; s2 = o1; }
        }
        E(acc, cur, wr, wc, fr, fq, pre);
        if (!has_next) break;
#pragma unroll
        for (int b = 0; b < 2; ++b)
#pragma unroll
            for (int m = 0; m < 4; ++m)
#pragma unroll
                for (int n = 0; n < 2; ++n) acc[0][b][m][n] = (f32x4){0.f, 0.f, 0.f, 0.f};
        cur = nxt; cA = nA; cB = nB; ++ui;
        E.pre(cur, wr, wc, fr, fq, pre);
    }
    PH_SYNC0();
#undef PH_STAGE
#undef PH_STAGE3
#undef PH_LDALL
#undef PH_MMA
#undef PH_SYNC6
#undef PH_SYNC0
}
template <class Epi, class Sched>
__device__ __forceinline__ void gemm_phase_h(PG8_LAS unsigned char* lds, const Gemm g, const Sched& S, const Epi& E) {
    if (__builtin_amdgcn_readfirstlane(threadIdx.x >> 8) == 0) gemm_phase_h_impl<Epi, Sched, false>(lds, g, S, E);
    else gemm_phase_h_impl<Epi, Sched, true>(lds, g, S, E);
}
}
#define XB_TMO      128
#define XB_XCNT(j)  (256  + 64 * (j))
#define XB_XSUB(j)  (1280 + 64 * (j))
#define XB_XGEN(j)  (2304 + 64 * (j))
#define XB_TOP      3328
#define XB_TOPGEN   3392
#define XCD_BAR_WORDS 3456
#define XB_SPIN_CAP (1u << 18)

__device__ __forceinline__ unsigned xb_ld(unsigned* p)              { return __hip_atomic_load(p, __ATOMIC_RELAXED, __HIP_MEMORY_SCOPE_AGENT); }
__device__ __forceinline__ unsigned xb_add(unsigned* p, unsigned v) { return __hip_atomic_fetch_add(p, v, __ATOMIC_RELAXED, __HIP_MEMORY_SCOPE_AGENT); }
__device__ __forceinline__ unsigned xb_xcc_id() { return (unsigned)__builtin_amdgcn_s_getreg((3 << 11) | 20) & 0xFu; }
#define XB_SPIN(cond, bar) do { unsigned _sp = 0; while (cond) { __builtin_amdgcn_s_sleep(1); \
    if ((++_sp & 255u) == 0u) { if (xb_ld(&(bar)[XB_TMO])) break; if (_sp > XB_SPIN_CAP) { atomicAdd(&(bar)[XB_TMO], 1u); break; } } } } while (0)

struct XcdBarrier {
    unsigned* bar; unsigned x;
    volatile LAS unsigned* st;
};

__device__ __forceinline__ XcdBarrier xcd_barrier_post(unsigned* bar, volatile LAS unsigned* st) {
    XcdBarrier b; b.bar = bar; b.x = xb_xcc_id(); b.st = st;
    if (threadIdx.x == 0) (void)xb_add(&bar[XB_XCNT(b.x)], 1u);
    return b;
}
__device__ __forceinline__ void xcd_barrier_complete(unsigned* bar, unsigned x, unsigned& nloc, unsigned& nx) {
    const unsigned G = gridDim.x * gridDim.y * gridDim.z;
    unsigned sum, cnt, mine, sp = 0u;
    for (;;) {
        sum = 0u; cnt = 0u; mine = 0u;
#pragma unroll
        for (unsigned j = 0; j < 16; ++j) { const unsigned c = xb_ld(&bar[XB_XCNT(j)]); sum += c; cnt += (c > 0u) ? 1u : 0u; mine = (j == x) ? c : mine; }
        if (sum == G) break;
        __builtin_amdgcn_s_sleep(1);
        if ((++sp & 255u) == 0u) { if (xb_ld(&bar[XB_TMO])) break; if (sp > XB_SPIN_CAP) { atomicAdd(&bar[XB_TMO], 1u); break; } }
    }
    nloc = mine > 0u ? mine : 1u; nx = cnt > 0u ? cnt : 1u;
}

__device__ __forceinline__ void xcd_barrier(const XcdBarrier& b) {
    asm volatile("s_waitcnt vmcnt(0)" ::: "memory");
    __syncthreads();
    if (threadIdx.x == 0) {
        unsigned* bar = b.bar;
        __builtin_amdgcn_s_waitcnt(0);
        unsigned nloc = b.st[0], nx = b.st[1];
        if (nloc == 0u) { xcd_barrier_complete(bar, b.x, nloc, nx); b.st[0] = nloc; b.st[1] = nx; }
        const unsigned old = xb_add(&bar[XB_XSUB(b.x)], 1u);
        const unsigned gen = old / nloc;
        if (old + 1u == (gen + 1u) * nloc) {
            __builtin_amdgcn_fence(__ATOMIC_RELEASE, "agent");
            asm volatile("s_waitcnt vmcnt(0)" ::: "memory");
            const unsigned og = xb_add(&bar[XB_TOP], 1u);
            const unsigned tg = og / nx;
            if (og + 1u == (tg + 1u) * nx) xb_add(&bar[XB_TOPGEN], 1u);
            else XB_SPIN(xb_ld(&bar[XB_TOPGEN]) == tg, bar);
            __builtin_amdgcn_fence(__ATOMIC_ACQUIRE, "agent");
            xb_add(&bar[XB_XGEN(b.x)], 1u);
            asm volatile("s_waitcnt vmcnt(0)" ::: "memory");
        } else {
            XB_SPIN(xb_ld(&bar[XB_XGEN(b.x)]) == gen, bar);
            __builtin_amdgcn_fence(__ATOMIC_ACQUIRE, "agent");
            asm volatile("s_waitcnt vmcnt(0)" ::: "memory");
        }
    }
    __syncthreads();
}
typedef unsigned short bf16_t;
typedef unsigned v4u __attribute__((ext_vector_type(4)));
typedef float f32x4 __attribute__((ext_vector_type(4)));
constexpr int D = 1024, NTOK = 8192, NCTX = 4096, DIN = 3072, DFF = 2816, DUP = 5632, NMOD = 6144;
constexpr float EPS = 1e-6f;
constexpr size_t MiB = 1u << 20;
constexpr size_t WS_BAR = 0, BAR_BYTES = 65536;
constexpr size_t WS_LAM = 64 * 1024, WS_ROPE = 72 * 1024, WS_KMAX = 80 * 1024, WS_MOD = 128 * 1024, WS_BIAS1 = 320 * 1024, WS_BIAS2 = 400 * 1024, WS_ROWSS = 576 * 1024;
constexpr int RS_STRIDE = 8704;
constexpr size_t WS_WIN = 1 * MiB, WS_WOUT = 13 * MiB, WS_WUP = 17 * MiB, WS_WDN = 39 * MiB;
constexpr size_t WS_XA = 50 * MiB, WS_ACT = 68 * MiB, WS_U = 112 * MiB;
constexpr size_t WS_BG = 112 * MiB, WS_P = 120 * MiB, WS_Q = 160 * MiB, WS_K = 168 * MiB, WS_V = 177 * MiB, WS_A2 = 186 * MiB;
constexpr size_t WS_XR = 202 * MiB;
constexpr size_t OUT_NK = 8388608, OUT_NV = 12582912;
constexpr int RING_BYTES = 147456, MISC_OFF = RING_BYTES, EDGE_OFF = RING_BYTES + 1024, LDS_BYTES = 163840;
constexpr int NWAVES = 8;

__device__ __forceinline__ float bf2f(bf16_t v) { return __uint_as_float(((unsigned)v) << 16); }
__device__ __forceinline__ unsigned f2bf(float f) { unsigned u = __float_as_uint(f); return (u + 0x7fffu + ((u >> 16) & 1u)) >> 16; }
__device__ __forceinline__ unsigned pk2(float lo, float hi) { return pg8::cvt_pk_bf16(lo, hi); }
__device__ __forceinline__ int grp_of(int r) { return r < NCTX ? 0 : 1 + ((r - NCTX) >> 11); }
__device__ __forceinline__ int krow_of(int r) { return r < NCTX ? r : NCTX + ((r - NCTX) >> 11) * 2304 + 256 + ((r - NCTX) & 2047); }
__device__ __forceinline__ float silu_f(float x) { return x / (1.f + expf(-x)); }
__device__ __forceinline__ float wave_sum(float v) { return pg8::xsum32(pg8::xsum16(pg8::rowsum16(v))); }
__device__ __forceinline__ float wave_max(float v) {
#pragma unroll
    for (int o = 1; o < 64; o <<= 1) v = fmaxf(v, __shfl_xor(v, o));
    return v;
}
#define LDS_WAIT() asm volatile("s_waitcnt lgkmcnt(0)" ::: "memory")

struct Args { const float* in[24]; float* out; unsigned char* ws; };
struct KA {
    __device__ __forceinline__ const float* operator[](int i) const { const __attribute__((address_space(4))) unsigned char* k = (const __attribute__((address_space(4))) unsigned char*)__builtin_amdgcn_kernarg_segment_ptr(); asm volatile("" : "+s"(k)); return ((const float* const __attribute__((address_space(4)))*)k)[i]; }
};
struct AV {
    KA in;
    __device__ __forceinline__ float* out_() const { return (float*)in[24]; }
    __device__ __forceinline__ unsigned char* ws_() const { return (unsigned char*)in[25]; }
};

__device__ __forceinline__ void p0_transpose_load(f32x4 (&wv)[8], const float* W, int N, int item, int lane) {
    const int nblk = N / 32, kb = item / nblk, nb = item % nblk, k0 = 64 * kb, n0 = 32 * nb;
#pragma unroll
    for (int i = 0; i < 8; ++i) wv[i] = __builtin_nontemporal_load((const f32x4*)&W[(size_t)(k0 + i * 8 + (lane >> 3)) * N + n0 + (lane & 7) * 4]);
}
template <int MAP> __device__ __forceinline__ void p0_transpose_item(const f32x4 (&wv)[8], int K, int N, bf16_t* WT, LAS float* scr, int item, int lane) {
    const int nblk = N / 32, kb = item / nblk, nb = item % nblk, k0 = 64 * kb, n0 = 32 * nb;
#pragma unroll
    for (int i = 0; i < 8; ++i) { LAS float* d = scr + (i * 8 + (lane >> 3)) * 33 + (lane & 7) * 4; d[0] = wv[i][0]; d[1] = wv[i][1]; d[2] = wv[i][2]; d[3] = wv[i][3]; }
    LDS_WAIT(); asm volatile("" ::: "memory");
    const int c = lane & 7;
#pragma unroll
    for (int j = 0; j < 4; ++j) { const int n = (lane >> 3) + 8 * j; const LAS float* s = scr + (8 * c) * 33 + n;
        v4u o; o.x = pk2(s[0 * 33], s[1 * 33]); o.y = pk2(s[2 * 33], s[3 * 33]); o.z = pk2(s[4 * 33], s[5 * 33]); o.w = pk2(s[6 * 33], s[7 * 33]);
        int prow = n0 + n; if (MAP == 1) { const int bj = prow / DFF, j = prow - bj * DFF; prow = (j >> 7) * 256 + bj * 128 + (j & 127); }
        if (MAP == 2) { if (prow < 1024) { const int w = prow & 255, d = w & 63; prow = (prow & ~255) + (d >> 5) * 128 + (w >> 6) * 32 + (d & 31); }
                        else if (prow >= 2048) { const int x = prow >= 2560, j = prow - (x ? 2560 : 2048); prow = (8 + (j >> 7)) * 256 + x * 128 + (j & 127); } }
        *(v4u*)(WT + (size_t)prow * K + k0 + 8 * c) = o; }
    LDS_WAIT(); asm volatile("" ::: "memory");
}

__device__ __forceinline__ void kmax_update(unsigned* p, float v) { atomicMax(p, __float_as_uint(v)); }
namespace pg8 {
template <int AI> struct EpiInProj {
    static constexpr bool PERM = false, AFTER_DRAIN = false;
    struct Pre { f32x4 bv[2][2]; float rss[AI][4]; };
    __device__ __forceinline__ void pre(const Unit& u, int wr, int wc, int fr, int fq, Pre& p) const {
        const int r0 = u.pm * (AI * HALF), pn = u.pn; const bool ctx = r0 < 4096; const int seqb = ctx ? 0 : (r0 - 4096) >> 11;
#pragma unroll
        for (int bj = 0; bj < 2; ++bj)
#pragma unroll
            for (int n = 0; n < 2; ++n) p.bv[bj][n] = *(const f32x4*)(bias + (size_t)(ctx ? 0 : 1 + seqb) * 3072 + pn * BM + bj * HALF + wc * 32 + n * 16 + 4 * fq);
#pragma unroll
        for (int ai = 0; ai < AI; ++ai)
#pragma unroll
            for (int m = 0; m < 4; ++m) p.rss[ai][m] = rowss[r0 + ai * HALF + wr * 64 + m * 16 + fr];
    }
    int l; const float* qg; const float* kg; const float* rope; bf16_t* Q; bf16_t* K; bf16_t* V; bf16_t* BG; bf16_t* P; float* out; unsigned* kmax; const float* rowss; const float* bias;
    __device__ __forceinline__ void operator()(f32x4 (&acc)[AI][2][4][2], const Unit& u, int wr, int wc, int fr_, int fq_, const Pre& pre_) const {
        int fr = fr_, fq = fq_; asm volatile("" : "+v"(fr), "+v"(fq));
        const int r0 = u.pm * (AI * HALF), pn = u.pn; const bool ctx = r0 < 4096;
        const int seqb = ctx ? 0 : (r0 - 4096) >> 11;
        {
#pragma unroll
          for (int ai = 0; ai < AI; ++ai)
#pragma unroll
              for (int m = 0; m < 4; ++m) { const float rs = __builtin_amdgcn_rsqf(pre_.rss[ai][m] * (1.f / 1024.f) + EPS);
#pragma unroll
                  for (int bj = 0; bj < 2; ++bj)
#pragma unroll
                      for (int n = 0; n < 2; ++n) acc[ai][bj][m][n] = acc[ai][bj][m][n] * rs + pre_.bv[bj][n]; } }
        if (pn < 4) {
            const bool isk = pn >= 2; const float* gw = isk ? kg : qg;
            f32x4 g[2][2];
#pragma unroll
            for (int bj = 0; bj < 2; ++bj)
#pragma unroll
                for (int n = 0; n < 2; ++n) g[bj][n] = *(const f32x4*)(gw + 32 * bj + 16 * n + 4 * fq);
            const int cb = 256 * (pn & 1) + 64 * wc + 4 * fq;
            float kmx = 0.f;
#pragma unroll
            for (int ai = 0; ai < AI; ++ai)
#pragma unroll
                for (int m = 0; m < 4; ++m) { const int row = r0 + ai * HALF + wr * 64 + m * 16 + fr;
                    float ss = 0.f;
#pragma unroll
                    for (int bj = 0; bj < 2; ++bj)
#pragma unroll
                        for (int n = 0; n < 2; ++n) { const f32x4 z = acc[ai][bj][m][n]; ss += (z[0] * z[0] + z[1] * z[1]) + (z[2] * z[2] + z[3] * z[3]); }
                    ss = xsum32(xsum16(ss));
                    const float rs = __builtin_amdgcn_rsqf(ss * (1.f / 64.f) + EPS) * (isk ? 1.f : 0.125f * 1.4426950408889634f);
                    f32x4 v[2][2]; float kss = 0.f;
#pragma unroll
                    for (int bj = 0; bj < 2; ++bj)
#pragma unroll
                        for (int n = 0; n < 2; ++n) { v[bj][n] = acc[ai][bj][m][n] * rs * g[bj][n]; const f32x4 q = v[bj][n]; kss += (q[0] * q[0] + q[1] * q[1]) + (q[2] * q[2] + q[3] * q[3]); }
                    if (isk) { kss = xsum32(xsum16(kss)); kmx = fmaxf(kmx, kss);
                        if (ctx) { float* nk = out + OUT_NK + ((size_t)((row >> 8) * 2 + l) * 256 + (row & 255)) * 512 + cb;
#pragma unroll
                            for (int bj = 0; bj < 2; ++bj)
#pragma unroll
                                for (int n = 0; n < 2; ++n) __builtin_nontemporal_store(v[bj][n], (f32x4*)(nk + 32 * bj + 16 * n)); } }
                    if (!ctx) { const int t = (row - 4096) & 2047;
#pragma unroll
                        for (int bj = 0; bj < 2; ++bj) { const int pos = bj ? (t & 63) : (t >> 6);
                            const f32x4 cs0 = *(const f32x4*)(rope + (pos * 16 + 4 * fq) * 2), cs1 = *(const f32x4*)(rope + (pos * 16 + 4 * fq) * 2 + 4);
                            const float c[4] = {cs0[0], cs0[2], cs1[0], cs1[2]}, s[4] = {cs0[1], cs0[3], cs1[1], cs1[3]};
                            const f32x4 x1 = v[bj][0], x2 = v[bj][1];
#pragma unroll
                            for (int e = 0; e < 4; ++e) { v[bj][0][e] = x1[e] * c[e] - x2[e] * s[e]; v[bj][1][e] = x2[e] * c[e] + x1[e] * s[e]; } } }
                    const int krow = ctx ? row : 4096 + seqb * 2304 + 256 + ((row - 4096) & 2047);
                    bf16_t* dst = (isk ? K + (size_t)krow * 512 : Q + (size_t)row * 512) + cb;
#pragma unroll
                    for (int bj = 0; bj < 2; ++bj) { const u32x4 w = pair16(v[bj][0], v[bj][1]); *(u32x4*)(dst - 4 * fq + 32 * bj + pair16_col(fq)) = w; }
                }
            if (isk) {
                kmx = fmaxf(kmx, __shfl_xor(kmx, 1)); kmx = fmaxf(kmx, __shfl_xor(kmx, 2)); kmx = fmaxf(kmx, __shfl_xor(kmx, 4)); kmx = fmaxf(kmx, __shfl_xor(kmx, 8));
                if (fr == 0 && fq == 0) kmax_update(kmax + l * 256 + (ctx ? (r0 >> 8) : 16 + seqb) * 8 + 4 * (pn & 1) + wc, kmx);
            }
        } else if (pn < 8) {
            const bool isv = pn < 6; const int cb = 256 * (pn & 1) + wc * 32 + 4 * fq;
#pragma unroll
            for (int ai = 0; ai < AI; ++ai)
#pragma unroll
                for (int m = 0; m < 4; ++m) { const int row = r0 + ai * HALF + wr * 64 + m * 16 + fr;
                    const int krow = ctx ? row : 4096 + seqb * 2304 + 256 + ((row - 4096) & 2047);
                    bf16_t* dst = (isv ? V + (size_t)krow * 512 : BG + (size_t)row * 512) + cb;
                    float* nv = out + OUT_NV + ((size_t)((row >> 8) * 2 + l) * 256 + (row & 255)) * 512 + cb;
#pragma unroll
                    for (int bj = 0; bj < 2; ++bj) { const u32x4 w = pair16(acc[ai][bj][m][0], acc[ai][bj][m][1]); *(u32x4*)(dst - 4 * fq + 128 * bj + pair16_col(fq)) = w;
#pragma unroll
                        for (int n = 0; n < 2; ++n) if (isv && ctx) __builtin_nontemporal_store(acc[ai][bj][m][n], (f32x4*)(nv + 128 * bj + 16 * n)); } }
        } else {
            const int cb = 128 * (pn - 8) + wc * 32 + 4 * fq;
#pragma unroll
            for (int ai = 0; ai < AI; ++ai)
#pragma unroll
                for (int m = 0; m < 4; ++m) { const int row = r0 + ai * HALF + wr * 64 + m * 16 + fr;
                    { const u32x4 w = pair16(acc[ai][0][m][0] * acc[ai][1][m][0], acc[ai][0][m][1] * acc[ai][1][m][1]); *(u32x4*)(P + (size_t)row * 512 + cb - 4 * fq + pair16_col(fq)) = w; } }
        }
    }
};
}
__device__ __forceinline__ void phase_prologue(const AV a, LAS unsigned char* lds, int tid, int lane, int wave, int vcu, int G) {
    unsigned char* ws = a.ws_();
    const int bx = blockIdx.x;
    for (int it = bx; it < 256; it += G) {
        LAS float* sc = (LAS float*)lds;
        LAS float* red = (LAS float*)(lds + 12288);
        __syncthreads();
        for (int i = tid; i < 1024; i += 512) { sc[i] = silu_f(a.in[5][i]); sc[1024 + i] = silu_f(a.in[4][i]); sc[2048 + i] = silu_f(a.in[4][1024 + i]); }
        __syncthreads();
        const int l = it >> 7, n0 = (it & 127) * 48, ln = lane < 48 ? lane : 47;
        const float* wp = a.in[6] + (size_t)l * D * NMOD + (size_t)(wave * 128) * NMOD + n0 + ln;
        float a0 = 0.f, a1 = 0.f, a2 = 0.f;
#pragma unroll 32
        for (int k = 0; k < 128; ++k) { const float wv = __builtin_nontemporal_load(&wp[(size_t)k * NMOD]); const int kk = wave * 128 + k; a0 += sc[kk] * wv; a1 += sc[1024 + kk] * wv; a2 += sc[2048 + kk] * wv; }
        red[(wave * 3 + 0) * 64 + lane] = a0; red[(wave * 3 + 1) * 64 + lane] = a1; red[(wave * 3 + 2) * 64 + lane] = a2;
        __syncthreads();
        if (wave < 3 && lane < 48) {
            float s = 0.f;
#pragma unroll
            for (int w = 0; w < 8; ++w) s += red[(w * 3 + wave) * 64 + lane];
            ((float*)(ws + WS_MOD))[((size_t)l * 3 + wave) * NMOD + n0 + lane] = s + a.in[7][l * NMOD + n0 + lane];
        }
        __syncthreads();
    }
    if (bx == G - 1) {
        if (tid < 2) {
            const int l = tid; float s1 = 0.f, s2 = 0.f;
            for (int i = 0; i < 64; ++i) { s1 += a.in[12][l * 64 + i] * a.in[13][l * 64 + i]; s2 += a.in[14][l * 64 + i] * a.in[15][l * 64 + i]; }
            const float lam_init = 0.8f - 0.6f * expf(-0.3f * (float)l);
            float* lam = (float*)(ws + WS_LAM);
            lam[l * 2 + 0] = expf(s1) - expf(s2) + lam_init; lam[l * 2 + 1] = lam_init;
        }
        for (int i = tid; i < 512; i += 512) ((unsigned*)(ws + WS_KMAX))[i] = 0u;
        float* rope = (float*)(ws + WS_ROPE);
        for (int i = tid; i < 64 * 16; i += 512) {
            const int pos = i >> 4, f = i & 15;
            const float ang = (float)pos * powf(10000.f, -(float)f / 16.f);
            rope[i * 2 + 0] = cosf(ang); rope[i * 2 + 1] = sinf(ang);
        }
    }
    for (int i = bx * 512 + tid; i < 4 * RS_STRIDE; i += G * 512) ((float*)(ws + WS_ROWSS))[i] = 0.f;
    LAS float* scr = (LAS float*)(lds + wave * 16384);
    const int gw = vcu * NWAVES + wave, NGW = G * NWAVES;
    constexpr int I_IN = (D / 64) * (DIN / 32), I_OUT = (D / 64) * (D / 32), I_UP = (D / 64) * (DUP / 32), I_DN = (DFF / 64) * (D / 32), I_L = I_IN + I_OUT + I_UP + I_DN;
    auto fetch = [&](f32x4 (&wv)[8], int it) {
        const int l = it / I_L; int r = it % I_L;
        if (r < I_IN) { p0_transpose_load(wv, a.in[9] + (size_t)l * D * DIN, DIN, r, lane); return; } r -= I_IN;
        if (r < I_OUT) { p0_transpose_load(wv, a.in[19] + (size_t)l * D * D, D, r, lane); return; } r -= I_OUT;
        if (r < I_UP) { p0_transpose_load(wv, a.in[21] + (size_t)l * D * DUP, DUP, r, lane); return; } r -= I_UP;
        p0_transpose_load(wv, a.in[23] + (size_t)l * DFF * D, D, r, lane);
    };
    f32x4 nx[8];
    if (gw < 2 * I_L) fetch(nx, gw);
    for (int it = gw; it < 2 * I_L; it += NGW) {
        f32x4 cu[8];
#pragma unroll
        for (int i = 0; i < 8; ++i) cu[i] = nx[i];
        if (it + NGW < 2 * I_L) fetch(nx, it + NGW);
        const int l = it / I_L; int r = it % I_L;
        if (r < I_IN) { p0_transpose_item<2>(cu, D, DIN, (bf16_t*)(ws + WS_WIN) + (size_t)l * DIN * D, scr, r, lane); continue; } r -= I_IN;
        if (r < I_OUT) { p0_transpose_item<0>(cu, D, D, (bf16_t*)(ws + WS_WOUT) + (size_t)l * D * D, scr, r, lane); continue; } r -= I_OUT;
        if (r < I_UP) { p0_transpose_item<1>(cu, D, DUP, (bf16_t*)(ws + WS_WUP) + (size_t)l * DUP * D, scr, r, lane); continue; } r -= I_UP;
        p0_transpose_item<0>(cu, DFF, D, (bf16_t*)(ws + WS_WDN) + (size_t)l * D * DFF, scr, r, lane);
    }
}

__device__ __forceinline__ void phase_prep(const AV a, int lane, int gw, int NGW) {
    unsigned char* ws = a.ws_();
    constexpr int CH = 9, NCI = (DIN + CH - 1) / CH, NCU = (DUP + CH - 1) / CH, NCL = NCI + NCU;
    for (int c = gw; c < 2 * NCL; c += NGW) {
        const int l = c / NCL; int cc = c - l * NCL;
        const bool up = cc >= NCI; if (up) cc -= NCI;
        const int nrows = up ? DUP : DIN, q0 = cc * CH;
        const bf16_t* wt = (up ? (const bf16_t*)(ws + WS_WUP) + (size_t)l * DUP * D : (const bf16_t*)(ws + WS_WIN) + (size_t)l * DIN * D) + lane * 16;
        const float* sh = (const float*)(ws + WS_MOD) + (size_t)l * 3 * NMOD + (up ? 3 * D : 0) + lane * 16;
        v4u w[CH][2];
#pragma unroll
        for (int i = 0; i < CH; ++i) { const int q = q0 + i < nrows ? q0 + i : nrows - 1; w[i][0] = *(const v4u*)(wt + (size_t)q * D); w[i][1] = *(const v4u*)(wt + (size_t)q * D + 8); }
        f32x4 t[3][4];
#pragma unroll
        for (int g = 0; g < 3; ++g)
#pragma unroll
            for (int j = 0; j < 4; ++j) t[g][j] = *(const f32x4*)(sh + (size_t)g * NMOD + 4 * j);
        float* dst = (up ? (float*)(ws + WS_BIAS2) + (size_t)l * 3 * DUP : (float*)(ws + WS_BIAS1) + (size_t)l * 3 * DIN) + (size_t)(lane < 3 ? lane : 0) * nrows;
        typedef __bf16 bf2_t __attribute__((ext_vector_type(2)));
        unsigned tp[3][8];
#pragma unroll
        for (int g = 0; g < 3; ++g)
#pragma unroll
            for (int j = 0; j < 4; ++j) { tp[g][2 * j] = pg8::cvt_pk_bf16(t[g][j][0], t[g][j][1]); tp[g][2 * j + 1] = pg8::cvt_pk_bf16(t[g][j][2], t[g][j][3]); }
#pragma unroll
        for (int i = 0; i < CH; ++i) {
            float s3[3];
#pragma unroll
            for (int g = 0; g < 3; ++g) { float acc = 0.f;
#pragma unroll
                for (int m = 0; m < 8; ++m) acc = __builtin_amdgcn_fdot2_f32_bf16(__builtin_bit_cast(bf2_t, m < 4 ? w[i][0][m & 3] : w[i][1][m & 3]), __builtin_bit_cast(bf2_t, tp[g][m]), acc, false);
                s3[g] = wave_sum(acc); }
            if (lane < 3 && q0 + i < nrows) dst[q0 + i] = lane == 0 ? s3[0] : (lane == 1 ? s3[1] : s3[2]);
        }
    }
    const float* g1 = a.in[8];
    f32x4 gn[4];
#pragma unroll
    for (int j = 0; j < 4; ++j) gn[j] = *(const f32x4*)(g1 + 4 * lane + 256 * j);
    for (int rb = gw; rb < NTOK; rb += 4 * NGW) {
        f32x4 v[4][4], mul[4][4];
#pragma unroll
        for (int i = 0; i < 4; ++i) { const int r = rb + i * NGW < NTOK ? rb + i * NGW : rb;
            const float* x = r < NCTX ? a.in[0] + (size_t)r * D : a.in[1] + (size_t)(r - NCTX) * D;
            const float* sc = (const float*)(ws + WS_MOD) + (size_t)grp_of(r) * NMOD + D;
            const bool same0 = i > 0 && grp_of(r) == grp_of(rb);
#pragma unroll
            for (int j = 0; j < 4; ++j) { v[i][j] = __builtin_nontemporal_load((const f32x4*)(x + 4 * lane + 256 * j)); if (same0) mul[i][j] = mul[0][j]; else mul[i][j] = *(const f32x4*)(sc + 4 * lane + 256 * j); } }
#pragma unroll
        for (int i = 0; i < 4; ++i)
#pragma unroll
            for (int j = 0; j < 4; ++j) { asm volatile("" : "+v"(v[i][j]), "+v"(mul[i][j])); }
#pragma unroll
        for (int i = 0; i < 4; ++i) { const int r = rb + i * NGW;
            if (r < NTOK) {
                float ss = 0.f;
#pragma unroll
                for (int j = 0; j < 4; ++j) ss += (v[i][j].x * v[i][j].x + v[i][j].y * v[i][j].y) + (v[i][j].z * v[i][j].z + v[i][j].w * v[i][j].w);
                ss = wave_sum(ss);
                if (lane == 0) ((float*)(ws + WS_ROWSS))[r] = ss;
                bf16_t* o = (bf16_t*)(ws + WS_XA) + (size_t)r * D;
#pragma unroll
                for (int j = 0; j < 4; ++j) { const int c = 4 * lane + 256 * j;
                    const f32x4 y = v[i][j] * gn[j] * (mul[i][j] + 1.f);
                    uint2 w2; w2.x = pk2(y.x, y.y); w2.y = pk2(y.z, y.w); *(uint2*)(o + c) = w2; } } }
    }
}

__device__ __forceinline__ void step_cache_rows(const AV a, int l, int lane, int gw, int NGW) {
    unsigned char* ws = a.ws_();
    for (int i = gw; i < 512; i += NGW) {
        const int b = i >> 8, pos = i & 255;
        const float* ck = a.in[2] + ((size_t)(b * 2 + l) * 256 + pos) * 512 + lane * 8;
        const float* cv = a.in[3] + ((size_t)(b * 2 + l) * 256 + pos) * 512 + lane * 8;
        const f32x4 k0 = __builtin_nontemporal_load((const f32x4*)ck), k1 = __builtin_nontemporal_load((const f32x4*)(ck + 4)), v0 = __builtin_nontemporal_load((const f32x4*)cv), v1 = __builtin_nontemporal_load((const f32x4*)(cv + 4));
        v4u kw, vw; kw.x = pk2(k0.x, k0.y); kw.y = pk2(k0.z, k0.w); kw.z = pk2(k1.x, k1.y); kw.w = pk2(k1.z, k1.w);
        vw.x = pk2(v0.x, v0.y); vw.y = pk2(v0.z, v0.w); vw.z = pk2(v1.x, v1.y); vw.w = pk2(v1.z, v1.w);
        float kss = (k0.x * k0.x + k0.y * k0.y) + (k0.z * k0.z + k0.w * k0.w) + (k1.x * k1.x + k1.y * k1.y) + (k1.z * k1.z + k1.w * k1.w);
        kss += __shfl_xor(kss, 1); kss += __shfl_xor(kss, 2); kss += __shfl_xor(kss, 4);
        if ((lane & 7) == 0) kmax_update((unsigned*)(ws + WS_KMAX) + l * 256 + (16 + b) * 8 + (lane >> 3), kss);
        *(v4u*)((bf16_t*)(ws + WS_K) + (size_t)(NCTX + b * 2304 + pos) * 512 + lane * 8) = kw;
        *(v4u*)((bf16_t*)(ws + WS_V) + (size_t)(NCTX + b * 2304 + pos) * 512 + lane * 8) = vw;
    }
}
__device__ __forceinline__ void convbr_rows(const AV a, int l, int rbase, int lane, int wave) {
    unsigned char* ws = a.ws_();
    const float* cw = a.in[17] + l * 3 * 512 + lane * 8;
    const float* gn = a.in[18] + l * 512 + lane * 8;
    v4u pc[2], pu[2], pd[2], bg[2];
    const v4u z4 = {0u, 0u, 0u, 0u};
#pragma unroll
    for (int k = 0; k < 2; ++k) { const int r = rbase + 2 * wave + k;
        const bool lat = r >= NCTX; const int t = lat ? ((r - NCTX) & 2047) : (r & 255), len = lat ? 2048 : 256;
        const bf16_t* P = (const bf16_t*)(ws + WS_P) + (size_t)r * 512 + lane * 8;
        pc[k] = *(const v4u*)P; pu[k] = (t > 0) ? *(const v4u*)(P - 512) : z4; pd[k] = (t < len - 1) ? *(const v4u*)(P + 512) : z4;
        bg[k] = *(const v4u*)((const bf16_t*)(ws + WS_BG) + (size_t)r * 512 + lane * 8); }
    float w0[8], w1[8], w2[8], g[8];
#pragma unroll
    for (int j = 0; j < 8; ++j) { w0[j] = cw[j]; w1[j] = cw[512 + j]; w2[j] = cw[1024 + j]; g[j] = gn[j]; }
#pragma unroll
    for (int k = 0; k < 2; ++k) { const int r = rbase + 2 * wave + k;
        float y[8]; float ss = 0.f;
#pragma unroll
        for (int j = 0; j < 8; ++j) {
            const float c = __uint_as_float((j & 1) ? (pc[k][j >> 1] & 0xffff0000u) : (pc[k][j >> 1] << 16)), u = __uint_as_float((j & 1) ? (pu[k][j >> 1] & 0xffff0000u) : (pu[k][j >> 1] << 16));
            const float d = __uint_as_float((j & 1) ? (pd[k][j >> 1] & 0xffff0000u) : (pd[k][j >> 1] << 16)), b = __uint_as_float((j & 1) ? (bg[k][j >> 1] & 0xffff0000u) : (bg[k][j >> 1] << 16));
            y[j] = b * (w0[j] * u + w1[j] * c + w2[j] * d); ss += y[j] * y[j]; }
        ss = wave_sum(ss);
        const float rs = __builtin_amdgcn_rsqf(ss * (1.f / 512.f) + EPS);
        v4u o; o.x = pk2(y[0] * rs * g[0], y[1] * rs * g[1]); o.y = pk2(y[2] * rs * g[2], y[3] * rs * g[3]); o.z = pk2(y[4] * rs * g[4], y[5] * rs * g[5]); o.w = pk2(y[6] * rs * g[6], y[7] * rs * g[7]);
        *(v4u*)((bf16_t*)(ws + WS_A2) + (size_t)r * D + 512 + lane * 8) = o; }
}

namespace att {
using bf16x8 = __attribute__((ext_vector_type(8))) short;
using s16x4  = __attribute__((ext_vector_type(4))) short;
using f32x16 = __attribute__((ext_vector_type(16))) float;
using u32x4  = __attribute__((ext_vector_type(4))) unsigned;
#define KSWZ(row, colB) ((row) * 256 + ((colB) ^ (((row) & 7) << 4)))
#define SBAR() __builtin_amdgcn_sched_barrier(0)
__device__ __forceinline__ int crow(int r, int hi) { return (r & 3) + 8 * (r >> 2) + 4 * hi; }
__device__ __forceinline__ unsigned cvtpk(float lo, float hi) { unsigned r; asm volatile("v_cvt_pk_bf16_f32 %0, %1, %2" : "=v"(r) : "v"(lo), "v"(hi)); return r; }
__device__ __forceinline__ int v_st(int k, int c) { const int kk = (k & ~0xC) | ((k & 4) << 1) | ((k & 8) >> 1); return ((kk >> 3) * 4 + (c >> 5)) * 512 + ((kk & 7) * 32 + (c & 31)) * 2; }
__device__ __forceinline__ int v_rd_base(int lane) { return ((lane & 3) << 3) | (((lane >> 2) & 3) << 6) | (((lane >> 4) & 1) << 5) | (((lane >> 5) & 1) << 8); }
constexpr int v_rd_off(int d0, int ks, int half) { return d0 * 512 + ks * 4096 + half * 2048; }
template <int OFF> __device__ __forceinline__ s16x4 tr_read(int vb) {
    s16x4 r; asm volatile("ds_read_b64_tr_b16 %0, %1 offset:%2" : "=&v"(r) : "v"(vb), "i"(OFF) : "memory"); return r;
}
template <int D0> __device__ __forceinline__ void pv_one(f32x16& od, int vb, bf16x8 pa0, bf16x8 pa1, bf16x8 pa2, bf16x8 pa3) {
    const s16x4 l0 = tr_read<v_rd_off(D0, 0, 0)>(vb), h0 = tr_read<v_rd_off(D0, 0, 1)>(vb), l1 = tr_read<v_rd_off(D0, 1, 0)>(vb), h1 = tr_read<v_rd_off(D0, 1, 1)>(vb);
    const s16x4 l2 = tr_read<v_rd_off(D0, 2, 0)>(vb), h2 = tr_read<v_rd_off(D0, 2, 1)>(vb), l3 = tr_read<v_rd_off(D0, 3, 0)>(vb), h3 = tr_read<v_rd_off(D0, 3, 1)>(vb);
    asm volatile("s_waitcnt lgkmcnt(0)" ::: "memory"); SBAR();
#define PK(L, H) (bf16x8){L[0], L[1], L[2], L[3], H[0], H[1], H[2], H[3]}
    od = __builtin_amdgcn_mfma_f32_32x32x16_bf16(pa0, PK(l0, h0), od, 0, 0, 0);
    od = __builtin_amdgcn_mfma_f32_32x32x16_bf16(pa1, PK(l1, h1), od, 0, 0, 0);
    od = __builtin_amdgcn_mfma_f32_32x32x16_bf16(pa2, PK(l2, h2), od, 0, 0, 0);
    od = __builtin_amdgcn_mfma_f32_32x32x16_bf16(pa3, PK(l3, h3), od, 0, 0, 0);
#undef PK
}
constexpr int LDS_STAGE = 65536, LDS_V = 0, LDS_K = 32768, LDS_P1 = 0, LDS_OT = 65536, LDS_WS = 98304;
constexpr float SC_C = 0.125f * 1.4426950408889634f;

__device__ __forceinline__ void attn_unit(const bf16_t* __restrict__ Qb, const bf16_t* __restrict__ Kh, const bf16_t* __restrict__ Vh, int nk, float kmax2_0, float kmax2_1,
                                          float lam, float lam_init, const float* __restrict__ subg, bf16_t* __restrict__ A2o, LAS unsigned char* lds, const AV a, int layer, int conv_rbase) {
    int tid_ = threadIdx.x; asm volatile("" : "+v"(tid_));
    const int tid = tid_, wave = __builtin_amdgcn_readfirstlane(tid >> 6), lane = tid & 63, r32 = lane & 31, hi = lane >> 5;
    const int qg = wave & 1, s = (wave >> 1) & 1, kh = wave >> 2;
    LAS float* li_l = (LAS float*)(lds + LDS_WS + wave * 256);
    LAS float* lpart = (LAS float*)(lds + LDS_WS + 2048);
    LAS float* OT = (LAS float*)(lds + LDS_OT);
    LAS float* OT1 = (LAS float*)(lds + 102400);
    LAS float* P1 = (LAS float*)(lds + LDS_P1);
    bf16x8 qr[4];
    const bf16_t* Qw = Qb + (size_t)(qg * 32 + r32) * 512 + s * 64 + hi * 8;
    float qss = 0.f;
#pragma unroll
    for (int d0 = 0; d0 < 4; ++d0) { qr[d0] = *(const bf16x8*)(Qw + d0 * 16);
#pragma unroll
        for (int j = 0; j < 8; ++j) { const float q = __uint_as_float(((unsigned)(unsigned short)qr[d0][j]) << 16); qss += q * q; } }
    qss = pg8::xsum32(qss);
    const float mC = -(sqrtf(qss * (s ? kmax2_1 : kmax2_0)) * 1.01f);
    f32x16 negm; { _Pragma("unroll") for (int r = 0; r < 16; ++r) negm[r] = mC; }
    const int vb0 = (int)(unsigned)(size_t)(lds + LDS_V) + v_rd_base(lane) + kh * 16384;
    unsigned soff[8];
#pragma unroll
    for (int i = 0; i < 8; ++i) { const int q = (wave & 1) * 8 + i;
        if (wave < 4) { const int sub = 2 * q + (lane >> 5), kk = (sub >> 2) * 8 + ((lane & 31) >> 2), c = (sub & 3) * 32 + (lane & 3) * 8;
                        const int k = (kk & ~0xC) | ((kk & 4) << 1) | ((kk & 8) >> 1); soff[i] = (unsigned)(k * 1024 + c * 2); }
        else          { const int row = q * 4 + (lane >> 4), ch = (lane & 15) ^ (row & 15); soff[i] = (unsigned)(row * 1024 + ch * 16); } }
    const char* gsrc = (const char*)(wave < 4 ? Vh : Kh) + (size_t)(((wave >> 1) & 1) * 64) * 1024;
    const int ldst = (wave >> 1) * 16384 + (wave & 1) * 8192;
#define STAGE(b, key0) do { const char* g_ = gsrc + (size_t)(key0) * 1024; _Pragma("unroll") for (int i = 0; i < 8; ++i) \
        __builtin_amdgcn_global_load_lds((const unsigned*)(g_ + soff[i]), (LAS unsigned*)(lds + (b) * LDS_STAGE + ldst + i * 1024), 16, 0, 0); } while (0)
#define LBARV() do { asm volatile("s_waitcnt vmcnt(0) lgkmcnt(0)" ::: "memory"); __builtin_amdgcn_s_barrier(); asm volatile("" ::: "memory"); } while (0)
    f32x16 o0 = {}, o1 = {}, o2 = {}, o3 = {}; float l = 0.f;
    const int NS = nk >> 7;
    STAGE(0, 0);
    convbr_rows(a, layer, conv_rbase, lane, wave);
    LBARV();
    const int ldsb = (int)(unsigned)(size_t)lds;
    int kad0, kad1, kad2, kad3;
    { const int sw = (r32 & 15) << 4, rb = ldsb + LDS_K + kh * 16384 + r32 * 256, cs = s * 128 + hi * 16;
      kad0 = rb + ((cs + 0 * 32) ^ sw); kad1 = rb + ((cs + 1 * 32) ^ sw); kad2 = rb + ((cs + 2 * 32) ^ sw); kad3 = rb + ((cs + 3 * 32) ^ sw); }
#define KRD(dst, addr, OFF) asm volatile("ds_read_b128 %0, %1 offset:%2" : "=&v"(dst) : "v"(addr), "i"(OFF) : "memory")
#define LWAIT(N) do { asm volatile("s_waitcnt lgkmcnt(%0)" :: "n"(N) : "memory"); SBAR(); } while (0)
#define EXPP(P, r) do { P[r] = __builtin_amdgcn_exp2f(P[r]); ps += P[r]; } while (0)
#define VGRP(D0, H, G) do { G##a = tr_read<v_rd_off(D0, 2 * (H), 0)>(vb); G##b = tr_read<v_rd_off(D0, 2 * (H), 1)>(vb); G##c = tr_read<v_rd_off(D0, 2 * (H) + 1, 0)>(vb); G##d = tr_read<v_rd_off(D0, 2 * (H) + 1, 1)>(vb); } while (0)
#define PK(L, H) (bf16x8){L[0], L[1], L[2], L[3], H[0], H[1], H[2], H[3]}
#define PK4(P, BASE, OUT) do { unsigned a0 = cvtpk(P[BASE + 0], P[BASE + 1]), a1 = cvtpk(P[BASE + 2], P[BASE + 3]);   \
    unsigned b0_ = cvtpk(P[BASE + 4], P[BASE + 5]), b1_ = cvtpk(P[BASE + 6], P[BASE + 7]);                              \
    auto r0 = __builtin_amdgcn_permlane32_swap(a0, b0_, false, false); auto r1 = __builtin_amdgcn_permlane32_swap(a1, b1_, false, false); \
    u32x4 w = {r0[0], r1[0], r0[1], r1[1]}; OUT = *reinterpret_cast<bf16x8*>(&w); } while (0)
#define MM(A, B, C) C = __builtin_amdgcn_mfma_f32_32x32x16_bf16(A, B, C, 0, 0, 0)
    for (int j = 0; j < NS; ++j) {
        const int b = j & 1, so = b * LDS_STAGE, vb = vb0 + so;
        bf16x8 kA0, kA1, kA2, kA3, kB0, kB1, kB2, kB3;
        s16x4 g0a, g0b, g0c, g0d, g1a, g1b, g1c, g1d, g2a, g2b, g2c, g2d, g3a, g3b, g3c, g3d;
        KRD(kA0, kad0 + so, 0); KRD(kA1, kad1 + so, 0); KRD(kA2, kad2 + so, 0); KRD(kA3, kad3 + so, 0);
        KRD(kB0, kad0 + so, 8192); KRD(kB1, kad1 + so, 8192); KRD(kB2, kad2 + so, 8192); KRD(kB3, kad3 + so, 8192);
        VGRP(0, 0, g0);
        if (j + 1 < NS) STAGE(b ^ 1, (j + 1) * 128);
        f32x16 p0, p1;
        float ps = 0.f;
        SBAR();
        LWAIT(11); p0 = __builtin_amdgcn_mfma_f32_32x32x16_bf16(kA0, qr[0], negm, 0, 0, 0); SBAR();
        LWAIT(10); MM(kA1, qr[1], p0); SBAR();
        LWAIT(9);  MM(kA2, qr[2], p0); SBAR();
        LWAIT(8);  MM(kA3, qr[3], p0); SBAR();
        LWAIT(7);  p1 = __builtin_amdgcn_mfma_f32_32x32x16_bf16(kB0, qr[0], negm, 0, 0, 0); SBAR();
        LWAIT(6);  MM(kB1, qr[1], p1); SBAR(); EXPP(p0, 0); EXPP(p0, 1); EXPP(p0, 2); EXPP(p0, 3); SBAR();
        LWAIT(5);  MM(kB2, qr[2], p1); SBAR(); EXPP(p0, 4); EXPP(p0, 5); EXPP(p0, 6); EXPP(p0, 7); SBAR();
        LWAIT(4);  MM(kB3, qr[3], p1); SBAR(); EXPP(p0, 8); EXPP(p0, 9); EXPP(p0, 10); EXPP(p0, 11); SBAR();
        VGRP(1, 0, g1);
        EXPP(p0, 12); EXPP(p0, 13); EXPP(p0, 14); EXPP(p0, 15);
        bf16x8 pa0, pa1, pa2, pa3;
        PK4(p0, 0, pa0); PK4(p0, 8, pa1);
        SBAR();
        LWAIT(4); MM(pa0, PK(g0a, g0b), o0); SBAR(); EXPP(p1, 0); EXPP(p1, 1); SBAR();
        MM(pa1, PK(g0c, g0d), o0); SBAR(); EXPP(p1, 2); EXPP(p1, 3); SBAR();
        VGRP(2, 0, g2); SBAR();
        LWAIT(4); MM(pa0, PK(g1a, g1b), o1); SBAR(); EXPP(p1, 4); EXPP(p1, 5); SBAR();
        MM(pa1, PK(g1c, g1d), o1); SBAR(); EXPP(p1, 6); EXPP(p1, 7); SBAR();
        VGRP(3, 0, g3); SBAR();
        LWAIT(4); MM(pa0, PK(g2a, g2b), o2); SBAR(); EXPP(p1, 8); EXPP(p1, 9); SBAR();
        MM(pa1, PK(g2c, g2d), o2); SBAR(); EXPP(p1, 10); EXPP(p1, 11); SBAR();
        VGRP(0, 1, g0); SBAR();
        LWAIT(4); MM(pa0, PK(g3a, g3b), o3); SBAR(); EXPP(p1, 12); EXPP(p1, 13); SBAR();
        MM(pa1, PK(g3c, g3d), o3); SBAR(); EXPP(p1, 14); EXPP(p1, 15); SBAR();
        VGRP(1, 1, g1);
        l += ps;
        PK4(p1, 0, pa2); PK4(p1, 8, pa3);
        SBAR();
        LWAIT(4); MM(pa2, PK(g0a, g0b), o0); MM(pa3, PK(g0c, g0d), o0); SBAR();
        VGRP(2, 1, g2); SBAR();
        LWAIT(4); MM(pa2, PK(g1a, g1b), o1); MM(pa3, PK(g1c, g1d), o1); SBAR();
        VGRP(3, 1, g3); SBAR();
        LWAIT(4); MM(pa2, PK(g2a, g2b), o2); MM(pa3, PK(g2c, g2d), o2); SBAR();
        LWAIT(0); MM(pa2, PK(g3a, g3b), o3); MM(pa3, PK(g3c, g3d), o3); SBAR();
        LBARV();
    }
#undef KRD
#undef LWAIT
#undef EXPP
#undef VGRP
#undef PK
#undef PK4
#undef MM
#undef STAGE
#undef LBARV
#define SLOAD(x)
#define SWRITE(x)
#undef SLOAD
#undef SWRITE
    l = pg8::xsum32(l);
    const int pair = qg * 2 + s;
    if (kh == 1) {
#pragma unroll
        for (int r = 0; r < 16; ++r) { P1[((pair * 4 + 0) * 16 + r) * 64 + lane] = o0[r]; P1[((pair * 4 + 1) * 16 + r) * 64 + lane] = o1[r];
                                       P1[((pair * 4 + 2) * 16 + r) * 64 + lane] = o2[r]; P1[((pair * 4 + 3) * 16 + r) * 64 + lane] = o3[r]; }
        if (hi == 0) lpart[pair * 32 + r32] = l;
    }
    __syncthreads();
    float rli[16];
    if (kh == 0) {
#pragma unroll
        for (int r = 0; r < 16; ++r) { o0[r] += P1[((pair * 4 + 0) * 16 + r) * 64 + lane]; o1[r] += P1[((pair * 4 + 1) * 16 + r) * 64 + lane];
                                       o2[r] += P1[((pair * 4 + 2) * 16 + r) * 64 + lane]; o3[r] += P1[((pair * 4 + 3) * 16 + r) * 64 + lane]; }
        l += lpart[pair * 32 + r32];
        if (hi == 0) li_l[r32] = l;
        asm volatile("s_waitcnt lgkmcnt(0)" ::: "memory");
        const float wgt = s ? lam : 1.f;
#pragma unroll
        for (int r = 0; r < 16; ++r) rli[r] = wgt * __builtin_amdgcn_rcpf(li_l[crow(r, hi)]);
        LAS float* OTs = s ? OT1 : OT;
#pragma unroll
        for (int r = 0; r < 16; ++r) { LAS float* row = OTs + (qg * 32 + crow(r, hi)) * 128 + r32; row[0] = o0[r] * rli[r]; row[32] = o1[r] * rli[r]; row[64] = o2[r] * rli[r]; row[96] = o3[r] * rli[r]; }
    }
    __syncthreads();
    const float g0 = subg[2 * lane], g1 = subg[2 * lane + 1];
#pragma unroll
    for (int i = 0; i < 8; ++i) { const int row = wave * 8 + i;
        const float x0 = OT[row * 128 + 2 * lane] - OT1[row * 128 + 2 * lane], x1 = OT[row * 128 + 2 * lane + 1] - OT1[row * 128 + 2 * lane + 1];
        const float ss = wave_sum(x0 * x0 + x1 * x1);
        const float rs = __builtin_amdgcn_rsqf(ss * (1.f / 128.f) + EPS) * (1.f - lam_init);
        *(unsigned*)(A2o + (size_t)row * 1024 + 2 * lane) = pk2(x0 * rs * g0, x1 * rs * g1); }
    __syncthreads();
}
#undef KSWZ
#undef SBAR
}

__device__ __forceinline__ void phase_attn(const AV a, int l, LAS unsigned char* lds) {
    unsigned char* ws = a.ws_();
    const int G = gridDim.x;
    const float lam = ((const float*)(ws + WS_LAM))[l * 2], lam_init = ((const float*)(ws + WS_LAM))[l * 2 + 1];
    const float* kmax = (const float*)(ws + WS_KMAX) + l * 256;
    for (int it = blockIdx.x; it < 512; it += G) {
        int r0, kbase, nk, h, seq;
        if (it < 256) { const int b = it >> 7, qb = it & 31; h = (it >> 5) & 3; r0 = NCTX + b * 2048 + qb * 64; kbase = NCTX + b * 2304; nk = 2304; seq = 16 + b; }
        else { const int i2 = it - 256, b = i2 >> 4, qb = i2 & 3; h = (i2 >> 2) & 3; r0 = b * 256 + qb * 64; kbase = b * 256; nk = 256; seq = b; }
        att::attn_unit((const bf16_t*)(ws + WS_Q) + (size_t)r0 * 512 + h * 128, (const bf16_t*)(ws + WS_K) + (size_t)kbase * 512 + h * 128,
                       (const bf16_t*)(ws + WS_V) + (size_t)kbase * 512 + h * 128, nk, kmax[seq * 8 + h * 2], kmax[seq * 8 + h * 2 + 1],
                       lam, lam_init, a.in[16] + l * 128, (bf16_t*)(ws + WS_A2) + (size_t)r0 * D + h * 128, lds, a, l, r0 + 16 * h);
    }
}

template <int L>
__device__ __forceinline__ void layer_body(const AV a, LAS unsigned char* lds, const XcdBarrier& bar) {
    int tid_ = threadIdx.x; asm volatile("" : "+v"(tid_));
    const int lane = tid_ & 63, wave = __builtin_amdgcn_readfirstlane(tid_ >> 6);
    const int G = gridDim.x, bx = blockIdx.x;
    const int vcu = (G % 8 == 0) ? (bx % 8) * (G / 8) + bx / 8 : bx;
    const int gw = vcu * NWAVES + wave, NGW = G * NWAVES;
    constexpr int l = L;
    step_cache_rows(a, l, lane, gw, NGW);
    { unsigned char* ws = a.ws_();
      pg8::Gemm g{(const bf16_t*)(ws + WS_XA), (const bf16_t*)(ws + WS_WIN) + (size_t)l * DIN * D, NTOK, DIN, D}; pg8::HalfOrderMix S; S.init(NTOK, DIN, G, bx);
      pg8::EpiInProj<1> E{l, a.in[10] + l * 64, a.in[11] + l * 64, (const float*)(ws + WS_ROPE), (bf16_t*)(ws + WS_Q), (bf16_t*)(ws + WS_K), (bf16_t*)(ws + WS_V), (bf16_t*)(ws + WS_BG), (bf16_t*)(ws + WS_P), a.out_(), (unsigned*)(ws + WS_KMAX),
                        (const float*)(ws + WS_ROWSS) + (size_t)(l * 2) * RS_STRIDE, (const float*)(ws + WS_BIAS1) + (size_t)l * 3 * DIN};
      pg8::gemm_phase_h<pg8::EpiInProj<1>, pg8::HalfOrderMix>(lds, g, S, E);
    }
    xcd_barrier(bar);
    phase_attn(a, l, lds);
    xcd_barrier(bar);
    { unsigned char* ws = a.ws_(); const float* mod = (const float*)(ws + WS_MOD) + (size_t)l * 3 * NMOD;
      pg8::Gemm g{(const bf16_t*)(ws + WS_A2), (const bf16_t*)(ws + WS_WOUT) + (size_t)l * D * D, NTOK, D, D}; pg8::HalfOrder S; S.init(NTOK, D, G, bx);
      pg8::EpiRes<1, l == 0 ? 0 : 1, 1> E{a.in[0], a.in[1], (bf16_t*)(ws + WS_XR), nullptr, mod + 2 * D, (bf16_t*)(ws + WS_XA), a.in[20] + l * D, mod + 4 * D, (float*)(ws + WS_ROWSS) + (size_t)(l * 2 + 1) * RS_STRIDE};
      pg8::gemm_phase_h<pg8::EpiRes<1, l == 0 ? 0 : 1, 1>, pg8::HalfOrder>(lds, g, S, E);
    }
    xcd_barrier(bar);
    { unsigned char* ws = a.ws_();
      pg8::Gemm g{(const bf16_t*)(ws + WS_XA), (const bf16_t*)(ws + WS_WUP) + (size_t)l * DUP * D, 34 * 256, DUP, D}; pg8::OrderUp S; S.init(34 * 256, DUP, G, bx);
      pg8::EpiSwiglu E{a.in[22] + (size_t)l * 3 * DUP, (bf16_t*)(ws + WS_ACT), (LAS float*)(lds + EDGE_OFF), (const float*)(ws + WS_ROWSS) + (size_t)(l * 2 + 1) * RS_STRIDE, (const float*)(ws + WS_BIAS2) + (size_t)l * 3 * DUP, (LAS float*)(lds + EDGE_OFF + 8192)};
      pg8::gemm_phase<pg8::EpiSwiglu, pg8::OrderUp, true, true>(lds, g, S, E);
    }
    xcd_barrier(bar);
    { unsigned char* ws = a.ws_(); const float* mod = (const float*)(ws + WS_MOD) + (size_t)l * 3 * NMOD;
      pg8::Gemm g{(const bf16_t*)(ws + WS_ACT), (const bf16_t*)(ws + WS_WDN) + (size_t)l * D * DFF, NTOK, D, DFF}; pg8::HalfOrder S; S.init(NTOK, D, G, bx);
      const float* modn = (const float*)(ws + WS_MOD) + (size_t)(l + 1) * 3 * NMOD;
      pg8::EpiRes<1, 1, l == 0 ? 1 : 0> E{nullptr, nullptr, (bf16_t*)(ws + WS_XR), a.out_(), mod + 5 * D, l == 0 ? (bf16_t*)(ws + WS_XA) : nullptr, a.in[8] + (l + 1) * D, modn + D, (float*)(ws + WS_ROWSS) + (size_t)((l + 1) * 2) * RS_STRIDE};
      pg8::gemm_phase_h<pg8::EpiRes<1, 1, l == 0 ? 1 : 0>, pg8::HalfOrder>(lds, g, S, E);
    }
}

__global__ void __launch_bounds__(512, 2) mk_fwd(Args args_unused) {
    const AV a{};
    extern __shared__ __attribute__((aligned(16))) unsigned char lds_raw[];
    LAS unsigned char* lds = (LAS unsigned char*)lds_raw;
    volatile LAS unsigned* MISC = (volatile LAS unsigned*)(lds + MISC_OFF);
    const int tid = threadIdx.x, lane = tid & 63, wave = __builtin_amdgcn_readfirstlane(tid >> 6);
    const int G = gridDim.x, bx = blockIdx.x;
    const int vcu = (G % 8 == 0) ? (bx % 8) * (G / 8) + bx / 8 : bx;
    const int gw = vcu * NWAVES + wave, NGW = G * NWAVES;
    unsigned char* ws = a.ws_();
    for (int u = tid; u < 64; u += 512) MISC[u] = 0u;
    __syncthreads();
    XcdBarrier bar = xcd_barrier_post((unsigned*)(ws + WS_BAR) + 4096, MISC + 8);

    phase_prologue(a, lds, tid, lane, wave, vcu, G);
    xcd_barrier(bar);
    { int t_ = threadIdx.x; asm volatile("" : "+v"(t_)); phase_prep(a, t_ & 63, vcu * NWAVES + __builtin_amdgcn_readfirstlane(t_ >> 6), G * NWAVES);
    }
    xcd_barrier(bar);
    layer_body<0>(a, lds, bar);
    xcd_barrier(bar);
    layer_body<1>(a, lds, bar);
}

extern "C" void kernel_launch(void* const* d_in, const int* in_sizes, int n_in, void* d_out, int out_size, void* d_ws, size_t ws_size, hipStream_t stream) {
    static int grid = 0;
    if (grid == 0) {
        int dev = 0, cus = 0, per_cu = 0;
        if (hipGetDevice(&dev) != hipSuccess || hipDeviceGetAttribute(&cus, hipDeviceAttributeMultiprocessorCount, dev) != hipSuccess) { fprintf(stderr, "kernel_launch: device query failed\n"); grid = -1; return; }
        if (hipFuncSetAttribute((const void*)mk_fwd, hipFuncAttributeMaxDynamicSharedMemorySize, LDS_BYTES) != hipSuccess) { fprintf(stderr, "kernel_launch: hipFuncSetAttribute failed\n"); grid = -1; return; }
        if (hipOccupancyMaxActiveBlocksPerMultiprocessor(&per_cu, (const void*)mk_fwd, NWAVES * 64, LDS_BYTES) != hipSuccess || per_cu < 1) { fprintf(stderr, "kernel_launch: occupancy query failed (%d)\n", per_cu); (void)hipGetLastError(); per_cu = 1; }
        if (per_cu > 1) per_cu = 1;
        grid = cus * per_cu;
    }
    if (grid < 0) return;
    (void)hipMemsetAsync((char*)d_ws + WS_BAR + 16384, 0, 16384, stream);
    Args a{};
    for (int i = 0; i < 24; ++i) a.in[i] = (const float*)d_in[i];
    a.out = (float*)d_out; a.ws = (unsigned char*)d_ws;
    void* args[] = {&a};
    hipError_t e = hipLaunchCooperativeKernel((const void*)mk_fwd, dim3(grid), dim3(NWAVES * 64), args, LDS_BYTES, stream);
    if (e != hipSuccess) fprintf(stderr, "kernel_launch: cooperative launch failed: %s (grid %d)\n", hipGetErrorString(e), grid);
}
```
